# Optimizing an MI355X kernel written in HIP

```python
import math
import jax, jax.numpy as jnp
from jax import lax
import numpy as np

D_MODEL = 1024
BATCH = 16
SEQ = 2048
DEPTH = 1
DEC_BATCH = 8
DEC_SEQ = 8192
PAST_LEN = 128

A_W = 512
N_HEADS = 4
QK_NOPE = 128
QK_ROPE = 64
V_DIM = 128
Q_LORA = 384
KV_LORA = 256
MLA_W = N_HEADS * V_DIM
MIX_W = A_W + MLA_W
IN_COLS = 3 * A_W + Q_LORA + KV_LORA + QK_ROPE
D_FF = 2816
CONV_W = 3
QBLK = 128
ROPE_THETA = 10000.0
ATTN_SCALE = 1.0 / math.sqrt(QK_NOPE + QK_ROPE)
EPS = 1e-6

kernel_name = "hybrid_conv_mla_adaln_encoder"


def rmsnorm(x, g):
    xf = x.astype(jnp.float32)
    y = xf * lax.rsqrt(jnp.mean(xf * xf, axis=-1, keepdims=True) + EPS)
    return (y * g.astype(jnp.float32)).astype(x.dtype)


def dwconv3(x, w):
    xp = jnp.pad(x, ((0, 0), (1, 1), (0, 0)))
    return xp[:, :-2] * w[0] + xp[:, 1:-1] * w[1] + xp[:, 2:] * w[2]


def rope_tables(s):
    inv = 1.0 / (ROPE_THETA ** (jnp.arange(0, QK_ROPE, 2, dtype=jnp.float32) / QK_ROPE))
    ang = jnp.arange(s, dtype=jnp.float32)[:, None] * inv[None, :]
    return jnp.cos(ang), jnp.sin(ang)


def apply_rope(x, cos, sin):
    c = cos[None, :, None, :].astype(x.dtype)
    s = sin[None, :, None, :].astype(x.dtype)
    x1, x2 = jnp.split(x, 2, axis=-1)
    return jnp.concatenate([x1 * c - x2 * s, x2 * c + x1 * s], axis=-1)


def mla_attention(q_nope, q_rope, k_nope, k_rope, v):
    b, s, h, _ = q_nope.shape
    nb = s // QBLK
    qn_b = q_nope.reshape(b, nb, QBLK, h, QK_NOPE).transpose(1, 0, 2, 3, 4)
    qr_b = q_rope.reshape(b, nb, QBLK, h, QK_ROPE).transpose(1, 0, 2, 3, 4)

    def block(args):
        qn, qr = args
        sc = (jnp.einsum('bqhd,bkhd->bhqk', qn, k_nope)
              + jnp.einsum('bqhr,bkr->bhqk', qr, k_rope)).astype(jnp.float32) * ATTN_SCALE
        p = jax.nn.softmax(sc, axis=-1).astype(v.dtype)
        return jnp.einsum('bhqk,bkhd->bqhd', p, v)

    o = lax.map(block, (qn_b, qr_b))
    return o.transpose(1, 0, 2, 3, 4).reshape(b, s, h * V_DIM)


def forward(x, c, w_ada, b_ada, norm1_g, w_in, conv_a_w, q_norm_g, w_uq, kv_norm_g, w_ukv,
            out_norm_a_g, out_norm_b_g, w_o, norm2_g, w_up, ffn_conv_w, w_down, final_g):
    b, s, _ = x.shape
    cos, sin = rope_tables(s)
    c_act = jax.nn.silu(c)
    for l in range(DEPTH):
        mod = (c_act @ w_ada[l] + b_ada[l])[:, None, :]
        sh1, sc1, g1, sh2, sc2, g2 = jnp.split(mod, 6, axis=-1)

        h = rmsnorm(x, norm1_g[l]) * (1.0 + sc1) + sh1
        z = h @ w_in[l]
        cuts = np.cumsum([A_W, A_W, A_W, Q_LORA, KV_LORA]).tolist()
        h_a, b_a, c_a, c_q, c_kv, k_r = jnp.split(z, cuts, axis=-1)

        y_a = b_a * dwconv3(c_a * h_a, conv_a_w[l])

        q = (rmsnorm(c_q, q_norm_g[l]) @ w_uq[l]).reshape(b, s, N_HEADS, QK_NOPE + QK_ROPE)
        q_nope, q_rope = q[..., :QK_NOPE], apply_rope(q[..., QK_NOPE:], cos, sin)
        kv = (rmsnorm(c_kv, kv_norm_g[l]) @ w_ukv[l]).reshape(b, s, N_HEADS, QK_NOPE + V_DIM)
        k_nope, v = kv[..., :QK_NOPE], kv[..., QK_NOPE:]
        k_rope = apply_rope(k_r[:, :, None, :], cos, sin)[:, :, 0, :]
        y_b = mla_attention(q_nope, q_rope, k_nope, k_rope, v)

        y = jnp.concatenate([rmsnorm(y_a, out_norm_a_g[l]), rmsnorm(y_b, out_norm_b_g[l])], axis=-1) @ w_o[l]
        x = x + g1 * y

        h = rmsnorm(x, norm2_g[l]) * (1.0 + sc2) + sh2
        u = dwconv3(h @ w_up[l], ffn_conv_w[l])
        gate, val = jnp.split(u, 2, axis=-1)
        x = x + g2 * ((jax.nn.silu(gate) * val) @ w_down[l])
    return rmsnorm(x, final_g)


def setup_inputs(seed: int = 0) -> dict:
    key = jax.random.key(seed)
    ks = jax.random.split(key, 24)
    f32 = jnp.float32

    def nrm(k, shape, scale):
        return jax.random.normal(k, shape, f32) * scale

    def gain(k, shape):
        return 1.0 + 0.05 * jax.random.normal(k, shape, f32)

    L = DEPTH
    return {
        "x_prompt": nrm(ks[0], (BATCH, SEQ, D_MODEL), 1.0),
        "x_sample": nrm(ks[1], (DEC_BATCH, DEC_SEQ, D_MODEL), 1.0),
        "c_prompt": nrm(ks[2], (BATCH, D_MODEL), 1.0),
        "c_sample": nrm(ks[3], (DEC_BATCH, D_MODEL), 1.0),
        "w_ada": nrm(ks[4], (L, D_MODEL, 6 * D_MODEL), 0.3 * D_MODEL ** -0.5),
        "b_ada": nrm(ks[5], (L, 6 * D_MODEL), 0.02),
        "norm1_g": gain(ks[6], (L, D_MODEL)),
        "w_in": nrm(ks[7], (L, D_MODEL, IN_COLS), D_MODEL ** -0.5),
        "conv_a_w": nrm(ks[8], (L, CONV_W, A_W), 0.5),
        "q_norm_g": gain(ks[9], (L, Q_LORA)),
        "w_uq": nrm(ks[10], (L, Q_LORA, N_HEADS * (QK_NOPE + QK_ROPE)), Q_LORA ** -0.5),
        "kv_norm_g": gain(ks[11], (L, KV_LORA)),
        "w_ukv": nrm(ks[12], (L, KV_LORA, N_HEADS * (QK_NOPE + V_DIM)), KV_LORA ** -0.5),
        "out_norm_a_g": gain(ks[13], (L, A_W)),
        "out_norm_b_g": gain(ks[14], (L, MLA_W)),
        "w_o": nrm(ks[15], (L, MIX_W, D_MODEL), MIX_W ** -0.5),
        "norm2_g": gain(ks[16], (L, D_MODEL)),
        "w_up": nrm(ks[17], (L, D_MODEL, 2 * D_FF), D_MODEL ** -0.5),
        "ffn_conv_w": nrm(ks[18], (L, CONV_W, 2 * D_FF), 0.5),
        "w_down": nrm(ks[19], (L, D_FF, D_MODEL), D_FF ** -0.5),
        "final_g": gain(ks[20], (D_MODEL,)),
    }


def reference(x_prompt, x_sample, c_prompt, c_sample, w_ada, b_ada, norm1_g, w_in, conv_a_w,
              q_norm_g, w_uq, kv_norm_g, w_ukv, out_norm_a_g, out_norm_b_g, w_o, norm2_g,
              w_up, ffn_conv_w, w_down, final_g):
    y_prompt = forward(x_prompt, c_prompt, w_ada, b_ada, norm1_g, w_in, conv_a_w, q_norm_g, w_uq,
                       kv_norm_g, w_ukv, out_norm_a_g, out_norm_b_g, w_o, norm2_g, w_up,
                       ffn_conv_w, w_down, final_g)
    y_sample = forward(x_sample, c_sample, w_ada, b_ada, norm1_g, w_in, conv_a_w, q_norm_g, w_uq,
                       kv_norm_g, w_ukv, out_norm_a_g, out_norm_b_g, w_o, norm2_g, w_up,
                       ffn_conv_w, w_down, final_g)
    return (y_prompt, y_sample)
```

```cpp
#include <hip/hip_runtime.h>
#include <hip/hip_cooperative_groups.h>
#include <cstdio>
#include <cstdint>
namespace cg = cooperative_groups;
namespace pg8 {
#define PG8_LAS __attribute__((address_space(3)))
typedef unsigned short bf16_t;
typedef short bf16x8 __attribute__((ext_vector_type(8)));
typedef float f32x4 __attribute__((ext_vector_type(4)));
typedef unsigned u32x4 __attribute__((ext_vector_type(4)));
constexpr int BM = 256, BK = 64, HALF = 128, HTB = HALF * BK * 2  , STAGE_BYTES = 8 * HTB, NXCD = 8, WGM = 8;

__host__ __device__ __forceinline__ int lds_byte(int r, int c) { const int st = (r >> 4) * 2 + (c >> 5), rr = r & 15, cc = c & 31, ob = rr * 64 + cc * 2; return st * 1024 + (ob ^ (((ob >> 9) & 1) << 5)); }
__host__ __device__ __forceinline__ void stage_rc(int b, int& R, int& C) { const int st = b / 1024, sb = b % 1024, swz = sb ^ (((sb >> 9) & 1) << 5); R = (st >> 1) * 16 + swz / 64; C = (st & 1) * 32 + (swz % 64) / 2; }
__host__ __device__ __forceinline__ int perm32(int rho) { const int n = rho >> 4, i = rho & 15; return 8 * (i >> 2) + 4 * n + (i & 3); }

struct Unit { int pm, pn, koff, nt; };
struct Gemm { const bf16_t* A; const bf16_t* Bt; int M, N, K; };

struct StaticOrder {
    int nM, nN, nwg, G, c, ntk;
    __host__ __device__ void init(int M, int N, int G_, int c_, int K_) { nM = M / BM; nN = N / BM; nwg = nM * nN; G = G_; c = c_; ntk = K_ / BK; }
    __host__ __device__ bool next(int i, Unit& u) const {
        const long L = (long)i * G + c; if (L >= nwg) return false;
        int wgid = (int)L; { const int q = nwg / NXCD, r = nwg % NXCD, xcd = wgid % NXCD, off = wgid / NXCD; wgid = (xcd < r ? xcd * (q + 1) : r * (q + 1) + (xcd - r) * q) + off; }
        const int nig = WGM * nN, gid = wgid / nig, fm = gid * WGM, gsz = (nM - fm) < WGM ? (nM - fm) : WGM;
        u.pm = fm + ((wgid % nig) % gsz); u.pn = (wgid % nig) / gsz; u.koff = 0; u.nt = ntk; return true;
    }
    __device__ __forceinline__ void a_ready(const Unit&) const {}
    __device__ __forceinline__ void done(const Unit&) const {}
};

__device__ __forceinline__ unsigned cvt_pk_bf16(float lo, float hi) { unsigned r; asm volatile("v_cvt_pk_bf16_f32 %0, %1, %2" : "=v"(r) : "v"(lo), "v"(hi)); return r; }
typedef float f32x2 __attribute__((ext_vector_type(2)));
struct SplitOrder {
    StaticOrder S; int split, h0;
    __host__ __device__ void init(int M, int N, int G_, int c_, int K_, int split_) { S.init(M, N, G_, c_, K_); split = split_; h0 = ((K_ / BK) / 4) * 2; }
    __host__ __device__ bool next(int i, Unit& u) const {
        if (!split) return S.next(i, u);
        if (i == 0) { if (!S.next(0, u)) return false; u.nt = h0; return true; }
        if (i == 1) { if (!S.next(0, u)) return false; u.koff = h0 * BK; u.nt = S.ntk - h0; return true; }
        return S.next(i - 1, u);
    }
    __device__ __forceinline__ void a_ready(const Unit&) const {}
    __device__ __forceinline__ void done(const Unit&) const {}
};
struct EpiBf16 {
    static constexpr bool PERM = true, AFTER_DRAIN = false;
    bf16_t* O; int ldc;
    __device__ __forceinline__ void operator()(const f32x4 (&acc)[2][2][4][2], const Unit& u, int wr, int wc, int fr, int fq) const {
        const int row0 = u.pm * BM + wr * 64 + fr; const int col0 = u.pn * BM + wc * 32 + 8 * fq;
#pragma unroll
        for (int ai = 0; ai < 2; ++ai)
#pragma unroll
            for (int m = 0; m < 4; ++m) { bf16_t* rowp = O + (size_t)(row0 + ai * HALF + m * 16) * ldc + col0;
#pragma unroll
                for (int bj = 0; bj < 2; ++bj) { const f32x4 v0 = acc[ai][bj][m][0], v1 = acc[ai][bj][m][1];
                    u32x4 w; w.x = cvt_pk_bf16(v0[0], v0[1]); w.y = cvt_pk_bf16(v0[2], v0[3]); w.z = cvt_pk_bf16(v1[0], v1[1]); w.w = cvt_pk_bf16(v1[2], v1[3]);
                    *(u32x4*)(rowp + bj * HALF) = w; } }
    }
};
struct EpiRes {
    static constexpr bool PERM = false, AFTER_DRAIN = false;
    const float* base_p; const float* base_s;
    float* out; const float* mod; int gate_off; int row_off;
    __device__ __forceinline__ void operator()(const f32x4 (&acc)[2][2][4][2], const Unit& u, int wr, int wc, int fr, int fq) const {
        const int t0 = row_off + u.pm * BM;
        const int bi = t0 < 32768 ? (t0 >> 11) : 16 + ((t0 - 32768) >> 13);
        const float* base = t0 < 32768 ? base_p : base_s;
        const float* gp = mod + bi * 6144 + gate_off;
        const int col0 = u.pn * BM + wc * 32 + 4 * fq;
        f32x4 gv[2][2];
#pragma unroll
        for (int bj = 0; bj < 2; ++bj)
#pragma unroll
            for (int n = 0; n < 2; ++n) gv[bj][n] = *(const f32x4*)(gp + col0 + bj * HALF + n * 16);
#pragma unroll
        for (int ai = 0; ai < 2; ++ai)
#pragma unroll
            for (int m = 0; m < 4; ++m) { const size_t off = (size_t)(t0 + ai * HALF + wr * 64 + m * 16 + fr) * 1024 + col0;
#pragma unroll
                for (int bj = 0; bj < 2; ++bj)
#pragma unroll
                    for (int n = 0; n < 2; ++n) { const f32x4 bs = *(const f32x4*)(base + off + bj * HALF + n * 16);
                        *(f32x4*)(out + off + bj * HALF + n * 16) = bs + gv[bj][n] * acc[ai][bj][m][n]; } }
    }
};

__device__ __forceinline__ float dpp_ror1(float x) { return __builtin_bit_cast(float, __builtin_amdgcn_update_dpp(0, __builtin_bit_cast(int, x), 0x121, 0xf, 0xf, false)); }
__device__ __forceinline__ float dpp_ror15(float x) { return __builtin_bit_cast(float, __builtin_amdgcn_update_dpp(0, __builtin_bit_cast(int, x), 0x12F, 0xf, 0xf, false)); }
struct EpiGate {
    static constexpr bool PERM = false, AFTER_DRAIN = false;
    bf16_t* ACT; bf16_t* UB; const float* cw; PG8_LAS f32x4* xl;
    static __device__ __forceinline__ int xi(int ai, int wr, int which, int wc, int bj, int n, int fq) { return (((((ai * 2 + wr) * 2 + which) * 4 + wc) * 2 + bj) * 2 + n) * 4 + fq; }
    __device__ __forceinline__ void operator()(const f32x4 (&acc)[2][2][4][2], const Unit& u, int wr, int wc, int fr, int fq) const {
        typedef unsigned u32x2v __attribute__((ext_vector_type(2)));
        const int colg = u.pn * 128 + wc * 32 + 4 * fq;
        if (fr == 0) {
#pragma unroll
            for (int ai = 0; ai < 2; ++ai)
#pragma unroll
                for (int bj = 0; bj < 2; ++bj)
#pragma unroll
                    for (int n = 0; n < 2; ++n) xl[xi(ai, wr, 0, wc, bj, n, fq)] = acc[ai][bj][0][n];
        }
        if (fr == 15) {
#pragma unroll
            for (int ai = 0; ai < 2; ++ai)
#pragma unroll
                for (int bj = 0; bj < 2; ++bj)
#pragma unroll
                    for (int n = 0; n < 2; ++n) xl[xi(ai, wr, 1, wc, bj, n, fq)] = acc[ai][bj][3][n];
        }
        if (wr == 0 && fr < 2) {
#pragma unroll
            for (int bj = 0; bj < 2; ++bj)
#pragma unroll
                for (int n = 0; n < 2; ++n) { const f32x4 v = acc[0][bj][0][n]; u32x2v w; w.x = cvt_pk_bf16(v[0], v[1]); w.y = cvt_pk_bf16(v[2], v[3]);
                    *(u32x2v*)(UB + ((size_t)u.pm * 4 + fr) * 5632 + bj * 2816 + colg + 16 * n) = w; }
        }
        if (wr == 1 && fr >= 14) {
#pragma unroll
            for (int bj = 0; bj < 2; ++bj)
#pragma unroll
                for (int n = 0; n < 2; ++n) { const f32x4 v = acc[1][bj][3][n]; u32x2v w; w.x = cvt_pk_bf16(v[0], v[1]); w.y = cvt_pk_bf16(v[2], v[3]);
                    *(u32x2v*)(UB + ((size_t)u.pm * 4 + (fr - 12)) * 5632 + bj * 2816 + colg + 16 * n) = w; }
        }
        f32x4 w[3][2];
#pragma unroll
        for (int k = 0; k < 3; ++k)
#pragma unroll
            for (int bj = 0; bj < 2; ++bj) w[k][bj] = *(const f32x4*)(cw + k * 5632 + bj * 2816 + colg);
        asm volatile("s_waitcnt lgkmcnt(0)\n\ts_barrier" ::: "memory");
#pragma unroll
        for (int n = 0; n < 2; ++n) {
            if (n == 1) {
#pragma unroll
                for (int k = 0; k < 3; ++k)
#pragma unroll
                    for (int bj = 0; bj < 2; ++bj) w[k][bj] = *(const f32x4*)(cw + k * 5632 + bj * 2816 + colg + 16);
            }
#pragma unroll
            for (int ai = 0; ai < 2; ++ai) {
                const int pai = wr == 1 ? ai : (ai > 0 ? ai - 1 : 0), pwr = wr ^ 1;
                const int nai = wr == 0 ? ai : (ai < 1 ? ai + 1 : 1), nwr = wr ^ 1;
                f32x4 pvf[2], nxl[2];
#pragma unroll
                for (int bj = 0; bj < 2; ++bj) { pvf[bj] = xl[xi(pai, pwr, 1, wc, bj, n, fq)]; nxl[bj] = xl[xi(nai, nwr, 0, wc, bj, n, fq)]; }
#pragma unroll
                for (int m = 0; m < 4; ++m) {
                    const int row = ai * HALF + wr * 64 + m * 16 + fr;
                    f32x4 cv[2];
#pragma unroll
                    for (int bj = 0; bj < 2; ++bj)
#pragma unroll
                        for (int j = 0; j < 4; ++j) {
                            const float cur = acc[ai][bj][m][n][j];
                            const float pr = m > 0 ? acc[ai][bj][m > 0 ? m - 1 : 0][n][j] : pvf[bj][j];
                            const float nr = m < 3 ? acc[ai][bj][m < 3 ? m + 1 : 3][n][j] : nxl[bj][j];
                            const float mixp = fr == 15 ? pr : cur, mixn = fr == 0 ? nr : cur;
                            float c = w[1][bj][j] * cur;
                            c = fmaf(dpp_ror1(mixp), w[0][bj][j], c);
                            c = fmaf(dpp_ror15(mixn), w[2][bj][j], c);
                            cv[bj][j] = c;
                        }
                    f32x4 o;
#pragma unroll
                    for (int j = 0; j < 4; ++j) o[j] = cv[0][j] * __builtin_amdgcn_rcpf(1.f + __expf(-cv[0][j])) * cv[1][j];
                    if (row != 0 && row != 255) { u32x2v pk; pk.x = cvt_pk_bf16(o[0], o[1]); pk.y = cvt_pk_bf16(o[2], o[3]);
                        *(u32x2v*)(ACT + (size_t)(u.pm * BM + row) * 2816 + colg + 16 * n) = pk; }
                }
            }
        }
    }
};

template <class Epi, class Sched, bool ALIGN_EPI = false, bool SP2 = false>
__device__ __forceinline__ void gemm_phase(PG8_LAS unsigned char* lds, const Gemm g, const Sched& S, const Epi& E) {
    int tid_ = threadIdx.x; asm volatile("" : "+v"(tid_));
    const int tid = tid_, wid = __builtin_amdgcn_readfirstlane(tid >> 6), lane = tid & 63, wr = wid >> 2, wc = wid & 3, fr = lane & 15, fq = lane >> 4;
    const int K = g.K, nt = K / BK;
    unsigned voffA[2], voffB[2];
#pragma unroll
    for (int i = 0; i < 2; ++i) { int R, C; stage_rc(tid * 16 + i * 8192, R, C); const int Rb = Epi::PERM ? ((R & ~31) + perm32(R & 31)) : R;
        voffA[i] = (unsigned)(R * K + C) * 2u; voffB[i] = (unsigned)(Rb * K + C) * 2u; }
    const size_t kstep = (size_t)(BK * 2);
    const size_t hstep = (size_t)HALF * K * 2;
    const size_t tstep = 2 * hstep;
    const unsigned ldsw = (unsigned)wid * 1024u;
    const int aoff = lds_byte(wr * 64 + fr, fq * 8), boff = lds_byte(wc * 32 + fr, fq * 8);
#define PG8_SA(b, h) (((b) * 2 + (h)) * HTB)
#define PG8_SB(b, h) ((4 + (b) * 2 + (h)) * HTB)
#define PG8_STAGE(bufoff, gbase, voff) do { _Pragma("unroll") for (int _i = 0; _i < 2; ++_i) \
        __builtin_amdgcn_global_load_lds((const unsigned*)((const char*)(gbase) + (voff)[_i]), (PG8_LAS unsigned*)(lds + (bufoff) + ldsw + _i * 8192), 16, 0, 0); } while (0)
#define PG8_LDA(dst, b, h) do { _Pragma("unroll") for (int m = 0; m < 4; ++m) _Pragma("unroll") for (int k = 0; k < 2; ++k) dst[m][k] = *(const PG8_LAS bf16x8*)(lds + PG8_SA(b, h) + aoff + m * 2048 + k * 1024); } while (0)
#define PG8_LDB(dst, b, h) do { _Pragma("unroll") for (int n = 0; n < 2; ++n) _Pragma("unroll") for (int k = 0; k < 2; ++k) dst[n][k] = *(const PG8_LAS bf16x8*)(lds + PG8_SB(b, h) + boff + n * 2048 + k * 1024); } while (0)
#define PG8_MMA(ai, bj, At, Bt) do { __builtin_amdgcn_s_setprio(1); _Pragma("unroll") for (int m = 0; m < 4; ++m) _Pragma("unroll") for (int n = 0; n < 2; ++n) _Pragma("unroll") for (int k = 0; k < 2; ++k) \
        acc[ai][bj][m][n] = __builtin_amdgcn_mfma_f32_16x16x32_bf16(Bt[n][k], At[m][k], acc[ai][bj][m][n], 0, 0, 0); __builtin_amdgcn_s_setprio(0); } while (0)
#define PG8_WAIT_V(n) asm volatile("s_waitcnt vmcnt(" #n ")" ::: "memory")
#define PG8_WAIT_L(n) asm volatile("s_waitcnt lgkmcnt(" #n ")" ::: "memory")
#define PG8_BAR __builtin_amdgcn_s_barrier()
#define PG8_SCHED __builtin_amdgcn_sched_barrier(0)
    Unit cur, nxt; int ui = 0;
    if (!S.next(0, cur)) return;
    f32x4 acc[2][2][4][2];
#pragma unroll
    for (int a = 0; a < 2; ++a)
#pragma unroll
        for (int b = 0; b < 2; ++b)
#pragma unroll
            for (int m = 0; m < 4; ++m)
#pragma unroll
                for (int n = 0; n < 2; ++n) acc[a][b][m][n] = (f32x4){0.f, 0.f, 0.f, 0.f};
    bf16x8 At[4][2], B0[2][2], B1[2][2];
    const char* cA = (const char*)g.A + (size_t)cur.pm * tstep + (size_t)cur.koff * 2; const char* cB = (const char*)g.Bt + (size_t)cur.pn * tstep + (size_t)cur.koff * 2;
    S.a_ready(cur);
    if constexpr (SP2) {
        PG8_STAGE(PG8_SB(0, 0), cB, voffB); PG8_STAGE(PG8_SB(0, 1), cB + hstep, voffB); PG8_STAGE(PG8_SA(0, 0), cA, voffA); PG8_STAGE(PG8_SA(0, 1), cA + hstep, voffA);
        if (wr == 1) PG8_BAR;
        PG8_WAIT_V(2); PG8_BAR;
        PG8_STAGE(PG8_SB(1, 0), cB + kstep, voffB); PG8_STAGE(PG8_SA(1, 0), cA + kstep, voffA); PG8_STAGE(PG8_SB(1, 1), cB + hstep + kstep, voffB);
        PG8_WAIT_V(6); PG8_BAR;
    } else {
        PG8_STAGE(PG8_SB(0, 0), cB, voffB); PG8_STAGE(PG8_SA(0, 0), cA, voffA); PG8_STAGE(PG8_SB(0, 1), cB + hstep, voffB); PG8_STAGE(PG8_SA(0, 1), cA + hstep, voffA);
        if (wr == 1) PG8_BAR;
        PG8_WAIT_V(4); PG8_BAR;
        PG8_STAGE(PG8_SB(1, 0), cB + kstep, voffB); PG8_STAGE(PG8_SA(1, 0), cA + kstep, voffA); PG8_STAGE(PG8_SB(1, 1), cB + hstep + kstep, voffB);
        PG8_WAIT_V(6); PG8_BAR;
    }
    for (;;) {
        const bool has_next = S.next(ui + 1, nxt);
        const char* nA = has_next ? (const char*)g.A + (size_t)nxt.pm * tstep + (size_t)nxt.koff * 2 : cA; const char* nB = has_next ? (const char*)g.Bt + (size_t)nxt.pn * tstep + (size_t)nxt.koff * 2 : cB;
        const int nt_u = cur.nt;
        for (int t = 0; t < nt_u; t += 2) {
            const bool last = (t == nt_u - 2);
            const char* a1 = cA + (size_t)(t + 1) * kstep;
            const char* a2 = last ? nA : cA + (size_t)(t + 2) * kstep; const char* b2 = last ? nB : cB + (size_t)(t + 2) * kstep;
            const char* a3 = a2 + kstep; const char* b3 = b2 + kstep;
            if (last && has_next) S.a_ready(nxt);
            if constexpr (SP2) {
            PG8_LDB(B0, 0, 0); PG8_LDB(B1, 0, 1); PG8_SCHED; PG8_LDA(At, 0, 0); PG8_STAGE(PG8_SA(1, 1), a1 + hstep, voffA);
            PG8_WAIT_V(8); PG8_WAIT_L(0); PG8_BAR; PG8_MMA(0, 0, At, B0); PG8_MMA(0, 1, At, B1); PG8_BAR; PG8_SCHED;
            PG8_LDA(At, 0, 1); PG8_STAGE(PG8_SB(0, 0), b2, voffB); PG8_STAGE(PG8_SB(0, 1), b2 + hstep, voffB); PG8_STAGE(PG8_SA(0, 0), a2, voffA);
            PG8_WAIT_V(8); PG8_WAIT_L(0); PG8_BAR; PG8_MMA(1, 0, At, B0); PG8_MMA(1, 1, At, B1); PG8_BAR; PG8_SCHED;
            PG8_LDB(B0, 1, 0); PG8_LDB(B1, 1, 1); PG8_SCHED; PG8_LDA(At, 1, 0); PG8_STAGE(PG8_SA(0, 1), a2 + hstep, voffA);
            PG8_WAIT_V(8); PG8_WAIT_L(0); PG8_BAR; PG8_MMA(0, 0, At, B0); PG8_MMA(0, 1, At, B1); PG8_BAR; PG8_SCHED;
            PG8_LDA(At, 1, 1); PG8_STAGE(PG8_SB(1, 0), b3, voffB); PG8_STAGE(PG8_SB(1, 1), b3 + hstep, voffB); PG8_STAGE(PG8_SA(1, 0), a3, voffA);
            PG8_WAIT_V(8); PG8_WAIT_L(0); PG8_BAR; PG8_MMA(1, 0, At, B0); PG8_MMA(1, 1, At, B1); PG8_BAR; PG8_SCHED;
            } else {
            PG8_LDB(B0, 0, 0); PG8_SCHED; PG8_LDA(At, 0, 0); PG8_STAGE(PG8_SA(1, 1), a1 + hstep, voffA);
            PG8_WAIT_L(8); PG8_BAR; PG8_WAIT_L(0); PG8_MMA(0, 0, At, B0); PG8_BAR; PG8_SCHED;
            PG8_LDB(B1, 0, 1); PG8_STAGE(PG8_SB(0, 0), b2, voffB);
            PG8_BAR; PG8_WAIT_L(0); PG8_MMA(0, 1, At, B1); PG8_BAR;
            PG8_LDA(At, 0, 1); PG8_STAGE(PG8_SA(0, 0), a2, voffA);
            PG8_BAR; PG8_WAIT_L(0); PG8_MMA(1, 0, At, B0); PG8_BAR; PG8_SCHED;
            PG8_STAGE(PG8_SB(0, 1), b2 + hstep, voffB);
            PG8_WAIT_V(6); PG8_BAR; PG8_MMA(1, 1, At, B1); PG8_BAR;
            PG8_LDB(B0, 1, 0); PG8_SCHED; PG8_LDA(At, 1, 0); PG8_STAGE(PG8_SA(0, 1), a2 + hstep, voffA);
            PG8_WAIT_L(8); PG8_BAR; PG8_WAIT_L(0); PG8_MMA(0, 0, At, B0); PG8_BAR; PG8_SCHED;
            PG8_LDB(B1, 1, 1); PG8_STAGE(PG8_SB(1, 0), b3, voffB);
            PG8_BAR; PG8_WAIT_L(0); PG8_MMA(0, 1, At, B1); PG8_BAR;
            PG8_LDA(At, 1, 1); PG8_STAGE(PG8_SA(1, 0), a3, voffA);
            PG8_BAR; PG8_WAIT_L(0); PG8_MMA(1, 0, At, B0); PG8_BAR; PG8_SCHED;
            PG8_STAGE(PG8_SB(1, 1), b3 + hstep, voffB);
            PG8_WAIT_V(6); PG8_BAR; PG8_MMA(1, 1, At, B1); PG8_BAR;
            }
        }
        if constexpr (ALIGN_EPI) { if (wr == 0) PG8_BAR; }
        if constexpr (!Epi::AFTER_DRAIN) { E(acc, cur, wr, wc, fr, fq); S.done(cur); }
        if (!has_next) break;
#pragma unroll
        for (int a = 0; a < 2; ++a)
#pragma unroll
            for (int b = 0; b < 2; ++b)
#pragma unroll
                for (int m = 0; m < 4; ++m)
#pragma unroll
                    for (int n = 0; n < 2; ++n) acc[a][b][m][n] = (f32x4){0.f, 0.f, 0.f, 0.f};
        cur = nxt; cA = nA; cB = nB; ++ui;
        if constexpr (ALIGN_EPI) { if (wr == 1) PG8_BAR; }
    }
    PG8_WAIT_V(0);
    if constexpr (!ALIGN_EPI) { if (wr == 0) PG8_BAR; }
    PG8_BAR;
    if constexpr (Epi::AFTER_DRAIN) { E.fused(acc, cur, wr, wc, fr, fq, lds, wid, lane); S.done(cur); }
#undef PG8_SA
#undef PG8_SB
#undef PG8_STAGE
#undef PG8_LDA
#undef PG8_LDB
#undef PG8_MMA
#undef PG8_WAIT_V
#undef PG8_WAIT_L
#undef PG8_BAR
#undef PG8_SCHED
}
}

constexpr int DM = 1024, T_P = 32768, T_ALL = 98304, S_P = 2048, S_S = 8192;
constexpr int ZC = 2304;
constexpr int DFF = 2816, UC = 2 * DFF;
constexpr float EPS = 1e-6f;
constexpr int NWAVES = 8;
constexpr int FFN_CHUNK = 32768, N_FFN_CHUNKS = 3;

#define LAS __attribute__((address_space(3)))
typedef unsigned short bf16_t;
typedef short bf16x8 __attribute__((ext_vector_type(8)));
typedef short s16x4 __attribute__((ext_vector_type(4)));
typedef float f32x4 __attribute__((ext_vector_type(4)));
typedef float f32x16 __attribute__((ext_vector_type(16)));
typedef unsigned u32x4 __attribute__((ext_vector_type(4)));
typedef unsigned u32x2 __attribute__((ext_vector_type(2)));

constexpr size_t MiB = 1u << 20;
constexpr size_t WS_MOD = 1 * MiB, WS_COS = 2 * MiB, WS_SIN = 3 * MiB;
constexpr size_t WS_WIN = 4 * MiB, WS_WUQ = 9 * MiB, WS_WUKV = 10 * MiB, WS_WO = 11 * MiB, WS_WUP = 13 * MiB, WS_WDN = 24 * MiB;
constexpr size_t WS_H = 32 * MiB;
constexpr size_t WS_Z = 224 * MiB;
constexpr size_t WS_QB = 224 * MiB, WS_KVB = 368 * MiB;
constexpr size_t WS_CQN = 656 * MiB, WS_CKVN = 728 * MiB, WS_KR = 776 * MiB;
constexpr size_t WS_YC = 788 * MiB;
constexpr size_t WS_ACT = 224 * MiB, WS_UB = 760 * MiB;
constexpr size_t WS_U_UNUSED = 0;
constexpr size_t WS_END = 980 * MiB;

constexpr int LDS_BYTES = 163840;

__device__ __forceinline__ float bf2f(unsigned short u) { return __uint_as_float((unsigned)u << 16); }
__device__ __forceinline__ float bflo(unsigned w) { return __uint_as_float(w << 16); }
__device__ __forceinline__ float bfhi(unsigned w) { return __uint_as_float(w & 0xffff0000u); }
__device__ __forceinline__ unsigned cvtpk(float lo, float hi) { unsigned r; asm volatile("v_cvt_pk_bf16_f32 %0, %1, %2" : "=v"(r) : "v"(lo), "v"(hi)); return r; }
__device__ __forceinline__ float wave_sum(float v) {
#pragma unroll
    for (int o = 1; o < 64; o <<= 1) v += __shfl_xor(v, o);
    return v;
}
__device__ __forceinline__ void unpack8(const u32x4 w, float* f) {
    f[0] = bflo(w.x); f[1] = bfhi(w.x); f[2] = bflo(w.y); f[3] = bfhi(w.y); f[4] = bflo(w.z); f[5] = bfhi(w.z); f[6] = bflo(w.w); f[7] = bfhi(w.w);
}
__device__ __forceinline__ u32x4 pack8(const float* f) {
    u32x4 w; w.x = cvtpk(f[0], f[1]); w.y = cvtpk(f[2], f[3]); w.z = cvtpk(f[4], f[5]); w.w = cvtpk(f[6], f[7]); return w;
}

namespace att {
constexpr float SCALE = 0.07216878364870322f;
constexpr float THR = 8.f;
constexpr float QC = SCALE * 1.4426950408889634f;
constexpr int SHM_V = 16384, SHM_K = 16384, SHM_KR = 8192;
constexpr int OFF_K = 0, OFF_KR = 3 * SHM_K, OFF_V = OFF_KR + 3 * SHM_KR, OFF_WS = OFF_V + 3 * SHM_V, OFF_QR = OFF_WS + 8 * 256, ATT_LDS = OFF_QR + 8 * 4096;
__device__ __forceinline__ void glds16(const void* gsrc, unsigned lds_dst) { unsigned keep;
    asm volatile("s_mov_b32 %0, m0\n\ts_mov_b32 m0, %2\n\ts_nop 0\n\tglobal_load_lds_dwordx4 %1, off\n\ts_mov_b32 m0, %0" : "=&s"(keep) : "v"(gsrc), "s"(lds_dst) : "memory"); }
#define KSWZ(row, colB) ((row) * 256 + ((colB) ^ (((row) & 15) << 4)))
#define KRSWZ(row, colB) ((row) * 128 + ((colB) ^ ((((row) >> 1) & 7) << 4)))
#define SBAR() __builtin_amdgcn_sched_barrier(0)
__device__ __forceinline__ int crow(int r, int hi) { return (r & 3) + 8 * (r >> 2) + 4 * hi; }

__device__ __forceinline__ void partialSM(f32x16& p0, f32x16& p1, float& m_ref, f32x16& negm, float& alpha, bool first) {
    constexpr float THR2 = THR * 1.4426950408889634f;
    float pmax = p0[0];
#pragma unroll
    for (int r = 1; r < 16; ++r) pmax = fmaxf(pmax, p0[r]);
#pragma unroll
    for (int r = 0; r < 16; ++r) pmax = fmaxf(pmax, p1[r]);
    { auto rr = __builtin_amdgcn_permlane32_swap(__float_as_uint(pmax), __float_as_uint(pmax), false, false);
      pmax = fmaxf(__uint_as_float(rr[0]), __uint_as_float(rr[1])); }
    if (__builtin_expect(!first && __all(pmax <= THR2), 1)) { alpha = 1.f; }
    else { const float d = first ? pmax : fmaxf(pmax, 0.f); m_ref += d; alpha = first ? 1.f : __builtin_amdgcn_exp2f(-d);
#pragma unroll
        for (int r = 0; r < 16; ++r) { p0[r] -= d; p1[r] -= d; }
#pragma unroll
        for (int r = 0; r < 16; ++r) negm[r] = -m_ref; }
#pragma unroll
    for (int r = 0; r < 16; ++r) p0[r] = __builtin_amdgcn_exp2f(p0[r]);
}
__device__ __forceinline__ void finishSM(f32x16& p0, f32x16& p1, float alpha, float& l_reg, bf16x8& pa0, bf16x8& pa1, bf16x8& pa2, bf16x8& pa3) {
#pragma unroll
    for (int r = 0; r < 16; ++r) p1[r] = __builtin_amdgcn_exp2f(p1[r]);
    float ps = 0;
#pragma unroll
    for (int r = 0; r < 16; ++r) ps += p0[r];
#pragma unroll
    for (int r = 0; r < 16; ++r) ps += p1[r];
    { auto rr = __builtin_amdgcn_permlane32_swap(__float_as_uint(ps), __float_as_uint(ps), false, false);
      ps = __uint_as_float(rr[0]) + __uint_as_float(rr[1]); }
    l_reg = l_reg * alpha + ps;
#define PK4(P, BASE, OUT) do { unsigned a0 = cvtpk(P[BASE + 0], P[BASE + 1]), a1 = cvtpk(P[BASE + 2], P[BASE + 3]);   \
    unsigned b0 = cvtpk(P[BASE + 4], P[BASE + 5]), b1 = cvtpk(P[BASE + 6], P[BASE + 7]);                              \
    auto r0 = __builtin_amdgcn_permlane32_swap(a0, b0, false, false); auto r1 = __builtin_amdgcn_permlane32_swap(a1, b1, false, false); \
    u32x4 w = {r0[0], r1[0], r0[1], r1[1]}; OUT = *reinterpret_cast<bf16x8*>(&w); } while (0)
    PK4(p0, 0, pa0); PK4(p0, 8, pa1); PK4(p1, 0, pa2); PK4(p1, 8, pa3);
#undef PK4
}
__device__ __forceinline__ void qkt(f32x16& p0, f32x16& p1, const char* Ks, const char* Krs, const bf16x8* qr, const char* qro, int r32, int hi, const f32x16& negm) {
    p0 = negm; p1 = negm;
#pragma unroll
    for (int d0 = 0; d0 < 8; ++d0) { const int cb = (d0 * 16 + hi * 8) * 2;
        const bf16x8 b0 = *reinterpret_cast<const bf16x8*>(Ks + KSWZ(r32, cb));
        const bf16x8 b1 = *reinterpret_cast<const bf16x8*>(Ks + KSWZ(32 + r32, cb));
        p0 = __builtin_amdgcn_mfma_f32_32x32x16_bf16(b0, qr[d0], p0, 0, 0, 0);
        p1 = __builtin_amdgcn_mfma_f32_32x32x16_bf16(b1, qr[d0], p1, 0, 0, 0); }
#pragma unroll
    for (int d0 = 0; d0 < 4; ++d0) { const int cb = (d0 * 16 + hi * 8) * 2;
        const bf16x8 b0 = *reinterpret_cast<const bf16x8*>(Krs + KRSWZ(r32, cb));
        const bf16x8 b1 = *reinterpret_cast<const bf16x8*>(Krs + KRSWZ(32 + r32, cb));
        const bf16x8 qf = qr[8 + d0];
        p0 = __builtin_amdgcn_mfma_f32_32x32x16_bf16(b0, qf, p0, 0, 0, 0);
        p1 = __builtin_amdgcn_mfma_f32_32x32x16_bf16(b1, qf, p1, 0, 0, 0); }
}
__device__ __forceinline__ int v_st(int k, int c) { const int kk = (k & ~0xC) | ((k & 4) << 1) | ((k & 8) >> 1); return ((kk >> 3) * 4 + (c >> 5)) * 512 + ((kk & 7) * 32 + (c & 31)) * 2; }
__device__ __forceinline__ int v_rd_base(int lane) { return ((lane & 3) << 3) | (((lane >> 2) & 3) << 6) | (((lane >> 4) & 1) << 5) | (((lane >> 5) & 1) << 8); }
constexpr int v_rd_off(int d0, int ks, int half) { return d0 * 512 + ks * 4096 + half * 2048; }
template <int OFF> __device__ __forceinline__ s16x4 tr_read(int vb) {
    s16x4 r; asm volatile("ds_read_b64_tr_b16 %0, %1 offset:%2" : "=&v"(r) : "v"(vb), "i"(OFF) : "memory"); return r;
}
template <int D0> __device__ __forceinline__ void pv_one(f32x16& od, int vb, bf16x8 pa0, bf16x8 pa1, bf16x8 pa2, bf16x8 pa3) {
    const s16x4 l0 = tr_read<v_rd_off(D0, 0, 0)>(vb), h0 = tr_read<v_rd_off(D0, 0, 1)>(vb), l1 = tr_read<v_rd_off(D0, 1, 0)>(vb), h1 = tr_read<v_rd_off(D0, 1, 1)>(vb);
    const s16x4 l2 = tr_read<v_rd_off(D0, 2, 0)>(vb), h2 = tr_read<v_rd_off(D0, 2, 1)>(vb), l3 = tr_read<v_rd_off(D0, 3, 0)>(vb), h3 = tr_read<v_rd_off(D0, 3, 1)>(vb);
    asm volatile("s_waitcnt lgkmcnt(0)" ::: "memory"); SBAR();
#define PK(L, H) (bf16x8){L[0], L[1], L[2], L[3], H[0], H[1], H[2], H[3]}
    od = __builtin_amdgcn_mfma_f32_32x32x16_bf16(pa0, PK(l0, h0), od, 0, 0, 0);
    od = __builtin_amdgcn_mfma_f32_32x32x16_bf16(pa1, PK(l1, h1), od, 0, 0, 0);
    od = __builtin_amdgcn_mfma_f32_32x32x16_bf16(pa2, PK(l2, h2), od, 0, 0, 0);
    od = __builtin_amdgcn_mfma_f32_32x32x16_bf16(pa3, PK(l3, h3), od, 0, 0, 0);
#undef PK
}
__device__ __forceinline__ void pv_d0(f32x16* o, int vb, bf16x8 pa0, bf16x8 pa1, bf16x8 pa2, bf16x8 pa3) {
    pv_one<0>(o[0], vb, pa0, pa1, pa2, pa3); pv_one<1>(o[1], vb, pa0, pa1, pa2, pa3); pv_one<2>(o[2], vb, pa0, pa1, pa2, pa3); pv_one<3>(o[3], vb, pa0, pa1, pa2, pa3);
}

__device__ __forceinline__ void attn_unit(const bf16_t* __restrict__ Qb, const bf16_t* __restrict__ Kh, const bf16_t* __restrict__ Vh, const bf16_t* __restrict__ Krh,
                                          bf16_t* __restrict__ Ob, const float* __restrict__ cosq, const float* __restrict__ sinq, int seq, char* lds) {
    int tid_ = threadIdx.x; asm volatile("" : "+v"(tid_));
    const int tid = tid_, wid = tid >> 6, lane = tid & 63, r32 = lane & 31, hi = lane >> 5;
    char* V_lds = lds + OFF_V; char* K_lds = lds + OFF_K; char* Kr_lds = lds + OFF_KR;
    float* ws = (float*)(lds + OFF_WS) + wid * 64; float* li_l = ws; float* al_l = ws + 32;
    float m_reg = 0.f, l_reg = 0; f32x16 negm = {}; f32x16 o[4] = {}; bf16x8 qr[12];
    const char* qro = nullptr;
    const bf16_t* Qw = Qb + (long)(wid * 32 + r32) * 768 + hi * 8;
#pragma unroll
    for (int d0 = 0; d0 < 8; ++d0) { float qf_[8]; unpack8(*reinterpret_cast<const u32x4*>(Qw + d0 * 16), qf_);
#pragma unroll
        for (int j = 0; j < 8; ++j) qf_[j] *= QC;
        qr[d0] = __builtin_bit_cast(bf16x8, pack8(qf_)); }
    {
        const float* cp = cosq + (wid * 32 + r32) * 32 + hi * 8; const float* sp = sinq + (wid * 32 + r32) * 32 + hi * 8;
#pragma unroll
        for (int g = 0; g < 2; ++g) {
            float c[8], s[8], x1[8], x2[8], y1[8], y2[8];
            *(f32x4*)&c[0] = *(const f32x4*)(cp + g * 16); *(f32x4*)&c[4] = *(const f32x4*)(cp + g * 16 + 4);
            *(f32x4*)&s[0] = *(const f32x4*)(sp + g * 16); *(f32x4*)&s[4] = *(const f32x4*)(sp + g * 16 + 4);
            unpack8(*reinterpret_cast<const u32x4*>(Qw + (8 + g) * 16), x1); unpack8(*reinterpret_cast<const u32x4*>(Qw + (10 + g) * 16), x2);
#pragma unroll
            for (int j = 0; j < 8; ++j) { y1[j] = (x1[j] * c[j] - x2[j] * s[j]) * QC; y2[j] = (x2[j] * c[j] + x1[j] * s[j]) * QC; }
            qr[8 + g] = __builtin_bit_cast(bf16x8, pack8(y1)); qr[10 + g] = __builtin_bit_cast(bf16x8, pack8(y2));
        }
    }
    const bf16_t* ksrc[2]; const bf16_t* vsrc[2]; const bf16_t* krsrc;
#pragma unroll
    for (int i = 0; i < 2; ++i) { const int p = (wid * 2 + i) * 64 + lane;
        { const int row = p >> 4, c = (p & 15) ^ (row & 15); ksrc[i] = Kh + (long)row * 1024 + c * 8; }
        { const int s = p >> 5, q = p & 31, kk = (s >> 2) * 8 + (q >> 2), k = (kk & ~0xC) | ((kk & 4) << 1) | ((kk & 8) >> 1), c = (s & 3) * 32 + (q & 3) * 8; vsrc[i] = Vh + (long)k * 1024 + c; } }
    { const int p = wid * 64 + lane, row = p >> 3, c = (p & 7) ^ ((row >> 1) & 7); krsrc = Krh + (long)row * 64 + c * 8; }
    const unsigned lds0 = (unsigned)(uintptr_t)lds;
    const unsigned kdst = lds0 + OFF_K + wid * 2048, krdst = lds0 + OFF_KR + wid * 1024, vdst = lds0 + OFF_V + wid * 2048;
#define DMA_K(t, slot) do { glds16(ksrc[0] + (long)(t) * 65536, (unsigned)__builtin_amdgcn_readfirstlane(kdst + (slot) * SHM_K)); \
    glds16(ksrc[1] + (long)(t) * 65536, (unsigned)__builtin_amdgcn_readfirstlane(kdst + (slot) * SHM_K + 1024)); \
    glds16(krsrc + (long)(t) * 4096, (unsigned)__builtin_amdgcn_readfirstlane(krdst + (slot) * SHM_KR)); } while (0)
#define DMA_V(t, slot) do { glds16(vsrc[0] + (long)(t) * 65536, (unsigned)__builtin_amdgcn_readfirstlane(vdst + (slot) * SHM_V)); \
    glds16(vsrc[1] + (long)(t) * 65536, (unsigned)__builtin_amdgcn_readfirstlane(vdst + (slot) * SHM_V + 1024)); } while (0)
#define WAIT_BAR(N) asm volatile("s_waitcnt vmcnt(" #N ") lgkmcnt(0)\n\ts_barrier" ::: "memory")
    const int vb0 = (int)(uintptr_t)V_lds + v_rd_base(lane);
    const int NT = seq / 64;
#define RESC(a) do { if (__any((a) < 1.f)) { if (hi == 0) al_l[r32] = (a); asm volatile("s_waitcnt lgkmcnt(0)" ::: "memory"); \
    _Pragma("unroll") for (int d = 0; d < 4; ++d) _Pragma("unroll") for (int r = 0; r < 16; ++r) o[d][r] *= al_l[crow(r, hi)]; } } while (0)
    f32x16 p0, p1; float al = 1.f, mn_; bf16x8 pa0, pa1, pa2, pa3;
    asm volatile("s_waitcnt vmcnt(0) lgkmcnt(0)" ::: "memory");
    DMA_K(0, 0); DMA_V(0, 0); DMA_K(1, 1);
    WAIT_BAR(0);
    int s0 = 2, s1 = 0, s2 = 1;
    for (int j = 0; j < NT; ++j) {
        if (j + 1 < NT) DMA_V(j + 1, s2);
        if (j + 2 < NT) DMA_K(j + 2, s0);
        qkt(p0, p1, K_lds + s1 * SHM_K, Kr_lds + s1 * SHM_KR, qr, qro, r32, hi, negm);
        partialSM(p0, p1, m_reg, negm, al, j == 0); finishSM(p0, p1, al, l_reg, pa0, pa1, pa2, pa3);
        RESC(al);
        pv_d0(o, vb0 + s1 * SHM_V, pa0, pa1, pa2, pa3);
        if (j + 2 < NT) { WAIT_BAR(3); } else { WAIT_BAR(0); }
        { const int t_ = s0; s0 = s1; s1 = s2; s2 = t_; }
    }
#undef RESC
#undef DMA_K
#undef DMA_V
#undef WAIT_BAR
    if (hi == 0) li_l[r32] = l_reg; asm volatile("s_waitcnt lgkmcnt(0)" ::: "memory");
    float rli[16];
#pragma unroll
    for (int r = 0; r < 16; ++r) rli[r] = __builtin_amdgcn_rcpf(li_l[crow(r, hi)]);
    bf16_t* Ow = Ob + (long)(wid * 32) * 1024;
#pragma unroll
    for (int r = 0; r < 16; ++r) { const int orow = crow(r, hi);
#pragma unroll
        for (int d0 = 0; d0 < 4; ++d0) Ow[(long)orow * 1024 + d0 * 32 + r32] = (bf16_t)(cvtpk(o[d0][r] * rli[r], 0.f) & 0xffffu); }
    asm volatile("s_waitcnt lgkmcnt(0)" ::: "memory");
}
}

#define GAS __attribute__((address_space(1)))
#define XB_TMO      128
#define XB_XCNT(j)  (256  + 64 * (j))
#define XB_XSUB(j)  (1280 + 64 * (j))
#define XB_XGEN(j)  (2304 + 64 * (j))
#define XB_TOP      3328
#define XB_TOPGEN   3392
#define XCD_BAR_WORDS 3456
#define XB_SPIN_CAP (1u << 18)

__device__ __forceinline__ unsigned xb_ld(unsigned* p)              { return __hip_atomic_load(p, __ATOMIC_RELAXED, __HIP_MEMORY_SCOPE_AGENT); }
__device__ __forceinline__ unsigned xb_add(unsigned* p, unsigned v) { return __hip_atomic_fetch_add(p, v, __ATOMIC_RELAXED, __HIP_MEMORY_SCOPE_AGENT); }
__device__ __forceinline__ unsigned xb_xcc_id() { return (unsigned)__builtin_amdgcn_s_getreg((3 << 11) | 20) & 0xFu; }
#define XB_SPIN(cond, bar) do { unsigned _sp = 0; while (cond) { __builtin_amdgcn_s_sleep(1); \
    if ((++_sp & 255u) == 0u) { if (xb_ld(&(bar)[XB_TMO])) break; if (_sp > XB_SPIN_CAP) { atomicAdd(&(bar)[XB_TMO], 1u); break; } } } } while (0)

struct XcdBarrier {
    unsigned* bar; unsigned x;
    volatile LAS unsigned* st;
};

__device__ __forceinline__ XcdBarrier xcd_barrier_post(unsigned* bar, volatile LAS unsigned* st) {
    XcdBarrier b; b.bar = bar; b.x = xb_xcc_id(); b.st = st;
    if (threadIdx.x == 0) (void)xb_add(&bar[XB_XCNT(b.x)], 1u);
    return b;
}
__device__ __forceinline__ void xcd_barrier_complete(unsigned* bar, unsigned x, unsigned& nloc, unsigned& nx) {
    const unsigned G = gridDim.x * gridDim.y * gridDim.z;
    unsigned sum, cnt, mine, sp = 0u;
    for (;;) {
        sum = 0u; cnt = 0u; mine = 0u;
#pragma unroll
        for (unsigned j = 0; j < 16; ++j) { const unsigned c = xb_ld(&bar[XB_XCNT(j)]); sum += c; cnt += (c > 0u) ? 1u : 0u; mine = (j == x) ? c : mine; }
        if (sum == G) break;
        __builtin_amdgcn_s_sleep(1);
        if ((++sp & 255u) == 0u) { if (xb_ld(&bar[XB_TMO])) break; if (sp > XB_SPIN_CAP) { atomicAdd(&bar[XB_TMO], 1u); break; } }
    }
    nloc = mine > 0u ? mine : 1u; nx = cnt > 0u ? cnt : 1u;
}

__device__ __forceinline__ void xcd_barrier(const XcdBarrier& b) {
    asm volatile("s_waitcnt vmcnt(0)" ::: "memory");
    __syncthreads();
    if (threadIdx.x == 0) {
        unsigned* bar = b.bar;
        __builtin_amdgcn_s_waitcnt(0);
        unsigned nloc = b.st[0], nx = b.st[1];
        if (nloc == 0u) { xcd_barrier_complete(bar, b.x, nloc, nx); b.st[0] = nloc; b.st[1] = nx; }
        const unsigned old = xb_add(&bar[XB_XSUB(b.x)], 1u);
        const unsigned gen = old / nloc;
        if (old + 1u == (gen + 1u) * nloc) {
            __builtin_amdgcn_fence(__ATOMIC_RELEASE, "agent");
            asm volatile("s_waitcnt vmcnt(0)" ::: "memory");
            const unsigned og = xb_add(&bar[XB_TOP], 1u);
            const unsigned tg = og / nx;
            if (og + 1u == (tg + 1u) * nx) xb_add(&bar[XB_TOPGEN], 1u);
            else XB_SPIN(xb_ld(&bar[XB_TOPGEN]) == tg, bar);
            __builtin_amdgcn_fence(__ATOMIC_ACQUIRE, "agent");
            xb_add(&bar[XB_XGEN(b.x)], 1u);
            asm volatile("s_waitcnt vmcnt(0)" ::: "memory");
        } else {
            XB_SPIN(xb_ld(&bar[XB_XGEN(b.x)]) == gen, bar);
            __builtin_amdgcn_fence(__ATOMIC_ACQUIRE, "agent");
            asm volatile("s_waitcnt vmcnt(0)" ::: "memory");
        }
    }
    __syncthreads();
}

struct Args { const float* in[21]; float* out; unsigned char* ws; };

struct Ctx {
    int tid, lane, wave, vcu, G, gw, NGW;
    LAS unsigned char* lds;
};

__device__ __forceinline__ void tok_info(int t, int& bi, int& pos, int& S) {
    if (t < T_P) { bi = t >> 11; pos = t & (S_P - 1); S = S_P; } else { const int u = t - T_P; bi = 16 + (u >> 13); pos = u & (S_S - 1); S = S_S; }
}

template <bool GATE_REMAP = false>
__device__ __forceinline__ void p0_transpose_item(const float* W, int K, int N, bf16_t* WT, LAS float* scr, int item, int lane) {
    const int nblk = N / 32, kb = item / nblk, nb = item % nblk, k0 = 64 * kb, n0 = 32 * nb;
    int nd0 = n0; if (GATE_REMAP) { const int half = n0 / DFF, cc = n0 % DFF; nd0 = (cc / 128) * 256 + half * 128 + (cc % 128); }
#pragma unroll 8
    for (int i = 0; i < 32; ++i) { const int kk = 2 * i + (lane >> 5); scr[kk * 33 + (lane & 31)] = W[(size_t)(k0 + kk) * N + n0 + (lane & 31)]; }
    asm volatile("s_waitcnt lgkmcnt(0)" ::: "memory");
    const int c = lane & 7;
#pragma unroll
    for (int j = 0; j < 4; ++j) { const int n = (lane >> 3) + 8 * j; const LAS float* s = scr + (8 * c) * 33 + n;
        u32x4 o; o.x = cvtpk(s[0 * 33], s[1 * 33]); o.y = cvtpk(s[2 * 33], s[3 * 33]); o.z = cvtpk(s[4 * 33], s[5 * 33]); o.w = cvtpk(s[6 * 33], s[7 * 33]);
        *(u32x4*)(WT + (size_t)(nd0 + n) * K + k0 + 8 * c) = o; }
    asm volatile("s_waitcnt lgkmcnt(0)" ::: "memory");
}

__device__ __forceinline__ void mod_gemv(const Ctx& X, const float* c_p, const float* c_s, const float* w_ada, const float* b_ada, float* mod, int j0) {
    LAS float* cact = (LAS float*)X.lds;
    for (int i = X.tid; i < 24 * 1024; i += 512) { const float c = i < 16 * 1024 ? c_p[i] : c_s[i - 16 * 1024]; cact[i] = c / (1.f + __expf(-c)); }
    __syncthreads();
    float acc[24];
#pragma unroll
    for (int b = 0; b < 24; ++b) acc[b] = 0.f;
    const int kbeg = X.wave * 128;
#pragma unroll 4
    for (int kk = 0; kk < 128; ++kk) { const int k = kbeg + kk; const float wv = w_ada[(size_t)k * 6144 + j0 + X.lane];
#pragma unroll
        for (int b = 0; b < 24; ++b) acc[b] = fmaf(cact[b * 1024 + k], wv, acc[b]); }
    __syncthreads();
    LAS float* red = (LAS float*)X.lds;
#pragma unroll
    for (int b = 0; b < 24; ++b) red[(X.wave * 24 + b) * 64 + X.lane] = acc[b];
    __syncthreads();
    for (int i = X.tid; i < 24 * 64; i += 512) { const int b = i >> 6, l = i & 63; float s = b_ada[j0 + l];
#pragma unroll
        for (int w = 0; w < 8; ++w) s += red[(w * 24 + b) * 64 + l];
        mod[b * 6144 + j0 + l] = s; }
    __syncthreads();
}

__device__ __forceinline__ void modnorm_phase(const Ctx& X, const float* src_p, const float* src_s, const float* g, const float* mod, int sh_off, int sc_off, bf16_t* H) {
    for (int ch = X.gw; ch < T_ALL / 16; ch += X.NGW) {
        const int t0 = ch * 16; int bi, pos, S; tok_info(t0, bi, pos, S);
        const float* src = t0 < T_P ? src_p : src_s;
        const float* mp = mod + bi * 6144;
        f32x4 gs[4], sh[4];
#pragma unroll
        for (int j = 0; j < 4; ++j) { const int c = X.lane * 4 + 256 * j; const f32x4 gg = *(const f32x4*)(g + c), sc = *(const f32x4*)(mp + sc_off + c);
            gs[j] = gg * (sc + 1.0f); sh[j] = *(const f32x4*)(mp + sh_off + c); }
#pragma unroll 2
        for (int r = 0; r < 16; ++r) {
            const float* xr = src + (size_t)(t0 + r) * DM + X.lane * 4;
            f32x4 v[4]; float ss = 0.f;
#pragma unroll
            for (int j = 0; j < 4; ++j) { v[j] = *(const f32x4*)(xr + 256 * j); ss += (v[j].x * v[j].x + v[j].y * v[j].y) + (v[j].z * v[j].z + v[j].w * v[j].w); }
            const float rstd = rsqrtf(wave_sum(ss) * (1.f / DM) + EPS);
            bf16_t* orow = H + (size_t)(t0 + r) * DM + X.lane * 4;
#pragma unroll
            for (int j = 0; j < 4; ++j) { const f32x4 o = v[j] * rstd * gs[j] + sh[j]; u32x2 w; w.x = cvtpk(o.x, o.y); w.y = cvtpk(o.z, o.w); *(u32x2*)(orow + 256 * j) = w; }
        }
    }
}

__device__ __forceinline__ void p3_phase(const Ctx& X, const bf16_t* Z, const float* conv_w, const float* ga, const float* gq, const float* gkv,
                                         const float* cosT, const float* sinT, bf16_t* YC, bf16_t* CQN, bf16_t* CKVN, bf16_t* KR) {
    const int lane = X.lane, c8 = lane * 8;
    float w0[8], w1[8], w2[8], gav[8], gqv[8], gkvv[8];
#pragma unroll
    for (int j = 0; j < 8; ++j) { w0[j] = conv_w[c8 + j]; w1[j] = conv_w[512 + c8 + j]; w2[j] = conv_w[1024 + c8 + j]; gav[j] = ga[c8 + j];
        gqv[j] = lane < 48 ? gq[c8 + j] : 0.f; gkvv[j] = lane < 32 ? gkv[c8 + j] : 0.f; }
    for (int ch = X.gw; ch < T_ALL / 16; ch += X.NGW) {
        const int t0 = ch * 16; int bi, pos0, S; tok_info(t0, bi, pos0, S);
        float prev[8], cur[8], nxt[8];
#define LOADP(dst, t) do { const u32x4 ha_ = *(const u32x4*)(Z + (size_t)(t) * ZC + c8), ca_ = *(const u32x4*)(Z + (size_t)(t) * ZC + 1024 + c8); \
        float hf_[8], cf_[8]; unpack8(ha_, hf_); unpack8(ca_, cf_); _Pragma("unroll") for (int j = 0; j < 8; ++j) dst[j] = hf_[j] * cf_[j]; } while (0)
        if (pos0 == 0) {
#pragma unroll
            for (int j = 0; j < 8; ++j) prev[j] = 0.f;
        } else LOADP(prev, t0 - 1);
        LOADP(cur, t0);
        for (int i = 0; i < 16; ++i) {
            const int t = t0 + i, pos = pos0 + i;
            if (pos == S - 1) {
#pragma unroll
                for (int j = 0; j < 8; ++j) nxt[j] = 0.f;
            } else LOADP(nxt, t + 1);
            const bf16_t* zr = Z + (size_t)t * ZC;
            float bf[8]; unpack8(*(const u32x4*)(zr + 512 + c8), bf);
            float y[8]; float ss_a = 0.f;
#pragma unroll
            for (int j = 0; j < 8; ++j) { y[j] = bf[j] * (w0[j] * prev[j] + w1[j] * cur[j] + w2[j] * nxt[j]); ss_a += y[j] * y[j]; }
            float q[8]; float ss_q = 0.f;
            if (lane < 48) { unpack8(*(const u32x4*)(zr + 1536 + c8), q);
#pragma unroll
                for (int j = 0; j < 8; ++j) ss_q += q[j] * q[j]; }
            float kv[8]; float ss_k = 0.f;
            if (lane < 32) { unpack8(*(const u32x4*)(zr + 1920 + c8), kv);
#pragma unroll
                for (int j = 0; j < 8; ++j) ss_k += kv[j] * kv[j]; }
#pragma unroll
            for (int o = 1; o < 64; o <<= 1) { ss_a += __shfl_xor(ss_a, o); ss_q += __shfl_xor(ss_q, o); ss_k += __shfl_xor(ss_k, o); }
            const float ra = rsqrtf(ss_a * (1.f / 512.f) + EPS), rq = rsqrtf(ss_q * (1.f / 384.f) + EPS), rk = rsqrtf(ss_k * (1.f / 256.f) + EPS);
#pragma unroll
            for (int j = 0; j < 8; ++j) y[j] = y[j] * ra * gav[j];
            *(u32x4*)(YC + (size_t)t * DM + c8) = pack8(y);
            if (lane < 48) {
#pragma unroll
                for (int j = 0; j < 8; ++j) q[j] = q[j] * rq * gqv[j];
                *(u32x4*)(CQN + (size_t)t * 384 + c8) = pack8(q); }
            if (lane < 32) {
#pragma unroll
                for (int j = 0; j < 8; ++j) kv[j] = kv[j] * rk * gkvv[j];
                *(u32x4*)(CKVN + (size_t)t * 256 + c8) = pack8(kv); }
            if (lane < 8) {
                const u32x2 a = *(const u32x2*)(zr + 2176 + lane * 4), b = *(const u32x2*)(zr + 2176 + 32 + lane * 4);
                const f32x4 c = *(const f32x4*)(cosT + pos * 32 + lane * 4), s = *(const f32x4*)(sinT + pos * 32 + lane * 4);
                const f32x4 x1 = {bflo(a.x), bfhi(a.x), bflo(a.y), bfhi(a.y)}, x2 = {bflo(b.x), bfhi(b.x), bflo(b.y), bfhi(b.y)};
                const f32x4 y1 = x1 * c - x2 * s, y2 = x2 * c + x1 * s;
                u32x2 o1, o2; o1.x = cvtpk(y1.x, y1.y); o1.y = cvtpk(y1.z, y1.w); o2.x = cvtpk(y2.x, y2.y); o2.y = cvtpk(y2.z, y2.w);
                *(u32x2*)(KR + (size_t)t * 64 + lane * 4) = o1; *(u32x2*)(KR + (size_t)t * 64 + 32 + lane * 4) = o2;
            }
#pragma unroll
            for (int j = 0; j < 8; ++j) { prev[j] = cur[j]; cur[j] = nxt[j]; }
        }
#undef LOADP
    }
}

__device__ __forceinline__ void p5b_phase(const Ctx& X, bf16_t* YC, const float* gb) {
    const int c8 = X.lane * 8; float g[8];
#pragma unroll
    for (int j = 0; j < 8; ++j) g[j] = gb[c8 + j];
    for (int ch = X.gw; ch < T_ALL / 16; ch += X.NGW) {
#pragma unroll 4
        for (int i = 0; i < 16; ++i) { bf16_t* p = YC + (size_t)(ch * 16 + i) * DM + 512 + c8;
            float v[8]; unpack8(*(const u32x4*)p, v); float ss = 0.f;
#pragma unroll
            for (int j = 0; j < 8; ++j) ss += v[j] * v[j];
            const float r = rsqrtf(wave_sum(ss) * (1.f / 512.f) + EPS);
#pragma unroll
            for (int j = 0; j < 8; ++j) v[j] = v[j] * r * g[j];
            *(u32x4*)p = pack8(v); }
    }
}

__device__ __forceinline__ void p9_fixup_phase(const Ctx& X, const bf16_t* UB, const float* cw, bf16_t* ACT) {
    const int nitems = (T_ALL / 256) * 2 * 6;
    for (int it = X.gw; it < nitems; it += X.NGW) {
        const int cb = it % 6, tb = it / 6, pm = tb >> 1, bot = tb & 1; const int c0 = cb * 512 + X.lane * 8;
        if (c0 >= DFF) continue;
        const int t = pm * 256 + (bot ? 255 : 0); const int S = t < T_P ? S_P : S_S; const int pos = t & (S - 1);
        const u32x4 zero = {0u, 0u, 0u, 0u};
        const bf16_t* r0; const bf16_t* r1; const bf16_t* r2; bool z0 = false, z2 = false;
        if (!bot) { z0 = (pos == 0); r0 = UB + ((size_t)(pm > 0 ? pm - 1 : 0) * 4 + 3) * UC; r1 = UB + ((size_t)pm * 4 + 0) * UC; r2 = UB + ((size_t)pm * 4 + 1) * UC; }
        else { z2 = (pos == S - 1); r0 = UB + ((size_t)pm * 4 + 2) * UC; r1 = UB + ((size_t)pm * 4 + 3) * UC; r2 = UB + ((size_t)(pm < T_ALL / 256 - 1 ? pm + 1 : pm) * 4 + 0) * UC; }
        float o[8], g[8], a[8], b[8], c[8];
        { const u32x4 x0 = z0 ? zero : *(const u32x4*)(r0 + c0), x1 = *(const u32x4*)(r1 + c0), x2 = z2 ? zero : *(const u32x4*)(r2 + c0);
          unpack8(x0, a); unpack8(x1, b); unpack8(x2, c);
#pragma unroll
          for (int j = 0; j < 8; ++j) g[j] = cw[c0 + j] * a[j] + cw[UC + c0 + j] * b[j] + cw[2 * UC + c0 + j] * c[j]; }
        { const u32x4 x0 = z0 ? zero : *(const u32x4*)(r0 + DFF + c0), x1 = *(const u32x4*)(r1 + DFF + c0), x2 = z2 ? zero : *(const u32x4*)(r2 + DFF + c0);
          unpack8(x0, a); unpack8(x1, b); unpack8(x2, c);
#pragma unroll
          for (int j = 0; j < 8; ++j) { const float v = cw[DFF + c0 + j] * a[j] + cw[UC + DFF + c0 + j] * b[j] + cw[2 * UC + DFF + c0 + j] * c[j]; o[j] = g[j] / (1.f + __expf(-g[j])) * v; } }
        *(u32x4*)(ACT + (size_t)t * DFF + c0) = pack8(o);
    }
}

__device__ __forceinline__ void final_norm_phase(const Ctx& X, float* out, const float* g) {
    f32x4 gv[4];
#pragma unroll
    for (int j = 0; j < 4; ++j) gv[j] = *(const f32x4*)(g + X.lane * 4 + 256 * j);
    for (int ch = X.gw; ch < T_ALL / 16; ch += X.NGW) {
#pragma unroll 2
        for (int r = 0; r < 16; ++r) { float* xr = out + (size_t)(ch * 16 + r) * DM + X.lane * 4;
            f32x4 v[4]; float ss = 0.f;
#pragma unroll
            for (int j = 0; j < 4; ++j) { v[j] = *(const f32x4*)(xr + 256 * j); ss += (v[j].x * v[j].x + v[j].y * v[j].y) + (v[j].z * v[j].z + v[j].w * v[j].w); }
            const float rstd = rsqrtf(wave_sum(ss) * (1.f / DM) + EPS);
#pragma unroll
            for (int j = 0; j < 4; ++j) *(f32x4*)(xr + 256 * j) = v[j] * rstd * gv[j]; }
    }
}

__global__ void __launch_bounds__(512, 2) fwd_kernel(Args args) {
    extern __shared__ __attribute__((aligned(16))) unsigned char lds[];
    cg::grid_group grid = cg::this_grid();
    Ctx X; { int t_ = threadIdx.x; asm volatile("" : "+v"(t_)); X.tid = t_; } X.lane = X.tid & 63; X.wave = __builtin_amdgcn_readfirstlane(X.tid >> 6);
    X.G = gridDim.x; { const int bx = blockIdx.x; X.vcu = (X.G % 8 == 0) ? (bx % 8) * (X.G / 8) + bx / 8 : bx; }
    X.gw = X.vcu * NWAVES + X.wave; X.NGW = X.G * NWAVES; X.lds = (LAS unsigned char*)lds;
    unsigned char* ws = args.ws;
    volatile LAS unsigned* bar_st = (volatile LAS unsigned*)(X.lds + (LDS_BYTES - 64));
    if (threadIdx.x < 2) bar_st[threadIdx.x] = 0u;
    __syncthreads();
    XcdBarrier bar = xcd_barrier_post((unsigned*)ws, bar_st);
    const float* x_p = args.in[0]; const float* x_s = args.in[1];
    float* mod = (float*)(ws + WS_MOD); float* cosT = (float*)(ws + WS_COS); float* sinT = (float*)(ws + WS_SIN);
    bf16_t* Win_t = (bf16_t*)(ws + WS_WIN); bf16_t* Wuq_t = (bf16_t*)(ws + WS_WUQ); bf16_t* Wukv_t = (bf16_t*)(ws + WS_WUKV);
    bf16_t* Wo_t = (bf16_t*)(ws + WS_WO); bf16_t* Wup_t = (bf16_t*)(ws + WS_WUP); bf16_t* Wdn_t = (bf16_t*)(ws + WS_WDN);
    bf16_t* H = (bf16_t*)(ws + WS_H); bf16_t* Z = (bf16_t*)(ws + WS_Z); bf16_t* QB = (bf16_t*)(ws + WS_QB); bf16_t* KVB = (bf16_t*)(ws + WS_KVB);
    bf16_t* CQN = (bf16_t*)(ws + WS_CQN); bf16_t* CKVN = (bf16_t*)(ws + WS_CKVN); bf16_t* KR = (bf16_t*)(ws + WS_KR); bf16_t* YC = (bf16_t*)(ws + WS_YC);
    bf16_t* ACT = (bf16_t*)(ws + WS_ACT); bf16_t* UB = (bf16_t*)(ws + WS_UB);
    float* out = args.out;

    {
#ifndef NO_MODGEMV
        if (blockIdx.x < 96) mod_gemv(X, args.in[2], args.in[3], args.in[4], args.in[5], mod, blockIdx.x * 64);
#endif
        LAS float* scr = (LAS float*)(X.lds + X.wave * 16384);
        constexpr int I_IN = 16 * 70, I_UQ = 6 * 24, I_UKV = 4 * 32, I_O = 16 * 32, I_UP = 16 * 176, I_DN = 44 * 32;
        constexpr int NITEMS = I_IN + I_UQ + I_UKV + I_O + I_UP + I_DN;
        for (int it = X.gw; it < NITEMS; it += X.NGW) {
            int r = it;
            if (r < I_IN) { p0_transpose_item(args.in[7], 1024, 2240, Win_t, scr, r, X.lane); continue; } r -= I_IN;
            if (r < I_UQ) { p0_transpose_item(args.in[10], 384, 768, Wuq_t, scr, r, X.lane); continue; } r -= I_UQ;
            if (r < I_UKV) { p0_transpose_item(args.in[12], 256, 1024, Wukv_t, scr, r, X.lane); continue; } r -= I_UKV;
            if (r < I_O) { p0_transpose_item(args.in[15], 1024, 1024, Wo_t, scr, r, X.lane); continue; } r -= I_O;
            if (r < I_UP) { p0_transpose_item<true>(args.in[17], 1024, 5632, Wup_t, scr, r, X.lane); continue; } r -= I_UP;
            p0_transpose_item(args.in[19], 2816, 1024, Wdn_t, scr, r, X.lane);
        }
        { const u32x4 zero = {0u, 0u, 0u, 0u}; u32x4* p = (u32x4*)(Win_t + (size_t)2240 * 1024);
          for (int i = blockIdx.x * 512 + X.tid; i < 64 * 1024 / 8; i += X.G * 512) p[i] = zero; }
        for (int i = blockIdx.x * 512 + X.tid; i < 8192 * 32; i += X.G * 512) {
            const int pos = i >> 5, k = i & 31;
            const double inv = exp2(-(double)k * (13.287712379549449 / 32.0));
            const double rev = (double)pos * inv * 0.15915494309189535;
            const float fr = (float)(rev - floor(rev));
            cosT[i] = __builtin_amdgcn_cosf(fr); sinT[i] = __builtin_amdgcn_sinf(fr);
        }
    }
    grid.sync();
    modnorm_phase(X, x_p, x_s - (size_t)T_P * DM, args.in[6], mod, 0, 1024, H);
    xcd_barrier(bar);
    {
        pg8::Gemm g{H, Win_t, T_ALL, ZC, 1024}; pg8::StaticOrder S; S.init(T_ALL, ZC, X.G, (int)blockIdx.x, 1024);
        pg8::EpiBf16 E{Z, ZC};
#ifndef NO_BF
        pg8::gemm_phase<pg8::EpiBf16, pg8::StaticOrder, true, true>(X.lds, g, S, E);
#endif
    }
    xcd_barrier(bar);
    p3_phase(X, Z, args.in[8], args.in[13], args.in[9], args.in[11], cosT, sinT, YC, CQN, CKVN, KR);
    xcd_barrier(bar);
    {
        pg8::Gemm g{CQN, Wuq_t, T_ALL, 768, 384}; pg8::StaticOrder S; S.init(T_ALL, 768, X.G, (int)blockIdx.x, 384);
        pg8::EpiBf16 E{QB, 768};
#ifndef NO_BF
        pg8::gemm_phase<pg8::EpiBf16, pg8::StaticOrder, true, true>(X.lds, g, S, E);
#endif
    }
    {
        pg8::Gemm g{CKVN, Wukv_t, T_ALL, 1024, 256}; pg8::StaticOrder S; S.init(T_ALL, 1024, X.G, (int)blockIdx.x, 256);
        pg8::EpiBf16 E{KVB, 1024};
#ifndef NO_BF
        pg8::gemm_phase<pg8::EpiBf16, pg8::StaticOrder, true, true>(X.lds, g, S, E);
#endif
    }
    xcd_barrier(bar);
    {
        for (int L = X.vcu; L < 1536; L += X.G) {
            int rowbase, h, q0, seq;
            if (L < 1024) { const int bh = L >> 5, qb = L & 31; rowbase = T_P + (bh >> 2) * S_S; h = bh & 3; q0 = qb * 256; seq = S_S; }
            else { const int l2 = L - 1024; const int bh = l2 >> 3, qb = l2 & 7; rowbase = (bh >> 2) * S_P; h = bh & 3; q0 = qb * 256; seq = S_P; }
#ifndef NO_ATT
            att::attn_unit(QB + (size_t)(rowbase + q0) * 768 + h * 192, KVB + (size_t)rowbase * 1024 + h * 256, KVB + (size_t)rowbase * 1024 + h * 256 + 128,
                           KR + (size_t)rowbase * 64, YC + (size_t)(rowbase + q0) * 1024 + 512 + h * 128, cosT + q0 * 32, sinT + q0 * 32, seq, (char*)lds);
#endif
        }
    }
    xcd_barrier(bar);
    p5b_phase(X, YC, args.in[14]);
    xcd_barrier(bar);
    {
        pg8::Gemm g{YC, Wo_t, T_ALL, 1024, 1024}; pg8::StaticOrder S; S.init(T_ALL, 1024, X.G, (int)blockIdx.x, 1024);
        pg8::EpiRes E{x_p, x_s - (size_t)T_P * DM, out, mod, 2048, 0};
#ifndef NO_RES
        pg8::gemm_phase<pg8::EpiRes, pg8::StaticOrder, true, true>(X.lds, g, S, E);
#endif
    }
    xcd_barrier(bar);
    modnorm_phase(X, out, out, args.in[16], mod, 3072, 4096, H);
    xcd_barrier(bar);
    {
        pg8::Gemm g{H, Wup_t, T_ALL, UC, 1024}; pg8::StaticOrder S; S.init(T_ALL, UC, X.G, (int)blockIdx.x, 1024);
        pg8::EpiGate E{ACT, UB, args.in[18], (LAS pg8::f32x4*)(X.lds + 131072)};
        pg8::gemm_phase<pg8::EpiGate, pg8::StaticOrder, true, true>(X.lds, g, S, E);
    }
    xcd_barrier(bar);
    p9_fixup_phase(X, UB, args.in[18], ACT);
    xcd_barrier(bar);
    {
        pg8::Gemm g{ACT, Wdn_t, T_ALL, 1024, DFF}; pg8::SplitOrder S; S.init(T_ALL, 1024, X.G, (int)blockIdx.x, DFF, (int)((blockIdx.x >> 3) & 1));
        pg8::EpiRes E{out, out, out, mod, 5120, 0};
        pg8::gemm_phase<pg8::EpiRes, pg8::SplitOrder, true, true>(X.lds, g, S, E);
    }
    xcd_barrier(bar);
    final_norm_phase(X, out, args.in[20]);
}

extern "C" void kernel_launch(void* const* d_in, const int* in_sizes, int n_in, void* d_out, int out_size, void* d_ws, size_t ws_size, hipStream_t stream) {
    static int grid = 0;
    if (grid == 0) {
        if (n_in != 21 || out_size != T_ALL * DM || ws_size < WS_END) { fprintf(stderr, "kernel_launch: unexpected shapes: n_in %d out %d ws %zu (need %zu)\n", n_in, out_size, ws_size, (size_t)WS_END); grid = -1; return; }
        int dev = 0, cus = 0, per_cu = 0;
        hipGetDevice(&dev); hipDeviceGetAttribute(&cus, hipDeviceAttributeMultiprocessorCount, dev);
        if (hipFuncSetAttribute((const void*)fwd_kernel, hipFuncAttributeMaxDynamicSharedMemorySize, LDS_BYTES) != hipSuccess) { fprintf(stderr, "kernel_launch: hipFuncSetAttribute failed\n"); grid = -1; return; }
        if (hipOccupancyMaxActiveBlocksPerMultiprocessor(&per_cu, (const void*)fwd_kernel, 512, LDS_BYTES) != hipSuccess || per_cu < 1) { fprintf(stderr, "kernel_launch: occupancy query says %d\n", per_cu); per_cu = 1; }
        (void)hipGetLastError();
        grid = cus * per_cu;
    }
    if (grid < 0) return;
    if (hipMemsetAsync(d_ws, 0, 16384, stream) != hipSuccess) { fprintf(stderr, "kernel_launch: hipMemsetAsync failed\n"); return; }
    Args a{};
    for (int i = 0; i < 21; ++i) a.in[i] = (const float*)d_in[i];
    a.out = (float*)d_out; a.ws = (unsigned char*)d_ws;
    void* kargs[] = {&a};
    hipError_t e = hipLaunchCooperativeKernel((const void*)fwd_kernel, dim3(grid), dim3(512), kargs, LDS_BYTES, stream);
    if (e != hipSuccess) fprintf(stderr, "kernel_launch: cooperative launch failed: %s (grid %d)\n", hipGetErrorString(e), grid);
}
```

```cpp
#include <hip/hip_runtime.h>
#include <hip/hip_cooperative_groups.h>
#include <cstdio>
#include <cstdint>
namespace cg = cooperative_groups;
namespace pg8 {
#define PG8_LAS __attribute__((address_space(3)))
typedef unsigned short bf16_t;
typedef short bf16x8 __attribute__((ext_vector_type(8)));
typedef float f32x4 __attribute__((ext_vector_type(4)));
typedef unsigned u32x4 __attribute__((ext_vector_type(4)));
constexpr int BM = 256, BK = 64, HALF = 128, HTB = HALF * BK * 2  , STAGE_BYTES = 8 * HTB, NXCD = 8, WGM = 8;

__host__ __device__ __forceinline__ int lds_byte(int r, int c) { const int st = (r >> 4) * 2 + (c >> 5), rr = r & 15, cc = c & 31, ob = rr * 64 + cc * 2; return st * 1024 + (ob ^ (((ob >> 9) & 1) << 5)); }
__host__ __device__ __forceinline__ void stage_rc(int b, int& R, int& C) { const int st = b / 1024, sb = b % 1024, swz = sb ^ (((sb >> 9) & 1) << 5); R = (st >> 1) * 16 + swz / 64; C = (st & 1) * 32 + (swz % 64) / 2; }
__host__ __device__ __forceinline__ int perm32(int rho) { const int n = rho >> 4, i = rho & 15; return 8 * (i >> 2) + 4 * n + (i & 3); }

struct Unit { int pm, pn, koff, nt; };
struct Gemm { const bf16_t* A; const bf16_t* Bt; int M, N, K; };

struct StaticOrder {
    int nM, nN, nwg, G, c, ntk;
    __host__ __device__ void init(int M, int N, int G_, int c_, int K_) { nM = M / BM; nN = N / BM; nwg = nM * nN; G = G_; c = c_; ntk = K_ / BK; }
    __host__ __device__ bool next(int i, Unit& u) const {
        const long L = (long)i * G + c; if (L >= nwg) return false;
        int wgid = (int)L; { const int q = nwg / NXCD, r = nwg % NXCD, xcd = wgid % NXCD, off = wgid / NXCD; wgid = (xcd < r ? xcd * (q + 1) : r * (q + 1) + (xcd - r) * q) + off; }
        const int nig = WGM * nN, gid = wgid / nig, fm = gid * WGM, gsz = (nM - fm) < WGM ? (nM - fm) : WGM;
        u.pm = fm + ((wgid % nig) % gsz); u.pn = (wgid % nig) / gsz; u.koff = 0; u.nt = ntk; return true;
    }
    __device__ __forceinline__ void a_ready(const Unit&) const {}
    __device__ __forceinline__ void done(const Unit&) const {}
};

__device__ __forceinline__ unsigned cvt_pk_bf16(float lo, float hi) { unsigned r; asm volatile("v_cvt_pk_bf16_f32 %0, %1, %2" : "=v"(r) : "v"(lo), "v"(hi)); return r; }
typedef float f32x2 __attribute__((ext_vector_type(2)));
struct SplitOrder {
    StaticOrder S; int split, h0;
    __host__ __device__ void init(int M, int N, int G_, int c_, int K_, int split_) { S.init(M, N, G_, c_, K_); split = split_; h0 = ((K_ / BK) / 4) * 2; }
    __host__ __device__ bool next(int i, Unit& u) const {
        if (!split) return S.next(i, u);
        if (i == 0) { if (!S.next(0, u)) return false; u.nt = h0; return true; }
        if (i == 1) { if (!S.next(0, u)) return false; u.koff = h0 * BK; u.nt = S.ntk - h0; return true; }
        return S.next(i - 1, u);
    }
    __device__ __forceinline__ void a_ready(const Unit&) const {}
    __device__ __forceinline__ void done(const Unit&) const {}
};
struct EpiBf16 {
    static constexpr bool PERM = true, AFTER_DRAIN = false;
    bf16_t* O; int ldc;
    __device__ __forceinline__ void operator()(const f32x4 (&acc)[2][2][4][2], const Unit& u, int wr, int wc, int fr, int fq) const {
        const int row0 = u.pm * BM + wr * 64 + fr; const int col0 = u.pn * BM + wc * 32 + 8 * fq;
#pragma unroll
        for (int ai = 0; ai < 2; ++ai)
#pragma unroll
            for (int m = 0; m < 4; ++m) { bf16_t* rowp = O + (size_t)(row0 + ai * HALF + m * 16) * ldc + col0;
#pragma unroll
                for (int bj = 0; bj < 2; ++bj) { const f32x4 v0 = acc[ai][bj][m][0], v1 = acc[ai][bj][m][1];
                    u32x4 w; w.x = cvt_pk_bf16(v0[0], v0[1]); w.y = cvt_pk_bf16(v0[2], v0[3]); w.z = cvt_pk_bf16(v1[0], v1[1]); w.w = cvt_pk_bf16(v1[2], v1[3]);
                    *(u32x4*)(rowp + bj * HALF) = w; } }
    }
};
struct EpiRes {
    static constexpr bool PERM = false, AFTER_DRAIN = false;
    const float* base_p; const float* base_s;
    float* out; const float* mod; int gate_off; int row_off;
    __device__ __forceinline__ void operator()(const f32x4 (&acc)[2][2][4][2], const Unit& u, int wr, int wc, int fr, int fq) const {
        const int t0 = row_off + u.pm * BM;
        const int bi = t0 < 32768 ? (t0 >> 11) : 16 + ((t0 - 32768) >> 13);
        const float* base = t0 < 32768 ? base_p : base_s;
        const float* gp = mod + bi * 6144 + gate_off;
        const int col0 = u.pn * BM + wc * 32 + 4 * fq;
        f32x4 gv[2][2];
#pragma unroll
        for (int bj = 0; bj < 2; ++bj)
#pragma unroll
            for (int n = 0; n < 2; ++n) gv[bj][n] = *(const f32x4*)(gp + col0 + bj * HALF + n * 16);
#pragma unroll
        for (int ai = 0; ai < 2; ++ai)
#pragma unroll
            for (int m = 0; m < 4; ++m) { const size_t off = (size_t)(t0 + ai * HALF + wr * 64 + m * 16 + fr) * 1024 + col0;
#pragma unroll
                for (int bj = 0; bj < 2; ++bj)
#pragma unroll
                    for (int n = 0; n < 2; ++n) { const f32x4 bs = *(const f32x4*)(base + off + bj * HALF + n * 16);
                        *(f32x4*)(out + off + bj * HALF + n * 16) = bs + gv[bj][n] * acc[ai][bj][m][n]; } }
    }
};

__device__ __forceinline__ float dpp_ror1(float x) { return __builtin_bit_cast(float, __builtin_amdgcn_update_dpp(0, __builtin_bit_cast(int, x), 0x121, 0xf, 0xf, false)); }
__device__ __forceinline__ float dpp_ror15(float x) { return __builtin_bit_cast(float, __builtin_amdgcn_update_dpp(0, __builtin_bit_cast(int, x), 0x12F, 0xf, 0xf, false)); }
struct EpiGate {
    static constexpr bool PERM = false, AFTER_DRAIN = false;
    bf16_t* ACT; bf16_t* UB; const float* cw; PG8_LAS f32x4* xl;
    static __device__ __forceinline__ int xi(int ai, int wr, int which, int wc, int bj, int n, int fq) { return (((((ai * 2 + wr) * 2 + which) * 4 + wc) * 2 + bj) * 2 + n) * 4 + fq; }
    __device__ __forceinline__ void operator()(const f32x4 (&acc)[2][2][4][2], const Unit& u, int wr, int wc, int fr, int fq) const {
        typedef unsigned u32x2v __attribute__((ext_vector_type(2)));
        const int colg = u.pn * 128 + wc * 32 + 4 * fq;
        if (fr == 0) {
#pragma unroll
            for (int ai = 0; ai < 2; ++ai)
#pragma unroll
                for (int bj = 0; bj < 2; ++bj)
#pragma unroll
                    for (int n = 0; n < 2; ++n) xl[xi(ai, wr, 0, wc, bj, n, fq)] = acc[ai][bj][0][n];
        }
        if (fr == 15) {
#pragma unroll
            for (int ai = 0; ai < 2; ++ai)
#pragma unroll
                for (int bj = 0; bj < 2; ++bj)
#pragma unroll
                    for (int n = 0; n < 2; ++n) xl[xi(ai, wr, 1, wc, bj, n, fq)] = acc[ai][bj][3][n];
        }
        if (wr == 0 && fr < 2) {
#pragma unroll
            for (int bj = 0; bj < 2; ++bj)
#pragma unroll
                for (int n = 0; n < 2; ++n) { const f32x4 v = acc[0][bj][0][n]; u32x2v w; w.x = cvt_pk_bf16(v[0], v[1]); w.y = cvt_pk_bf16(v[2], v[3]);
                    *(u32x2v*)(UB + ((size_t)u.pm * 4 + fr) * 5632 + bj * 2816 + colg + 16 * n) = w; }
        }
        if (wr == 1 && fr >= 14) {
#pragma unroll
            for (int bj = 0; bj < 2; ++bj)
#pragma unroll
                for (int n = 0; n < 2; ++n) { const f32x4 v = acc[1][bj][3][n]; u32x2v w; w.x = cvt_pk_bf16(v[0], v[1]); w.y = cvt_pk_bf16(v[2], v[3]);
                    *(u32x2v*)(UB + ((size_t)u.pm * 4 + (fr - 12)) * 5632 + bj * 2816 + colg + 16 * n) = w; }
        }
        f32x4 w[3][2];
#pragma unroll
        for (int k = 0; k < 3; ++k)
#pragma unroll
            for (int bj = 0; bj < 2; ++bj) w[k][bj] = *(const f32x4*)(cw + k * 5632 + bj * 2816 + colg);
        asm volatile("s_waitcnt lgkmcnt(0)\n\ts_barrier" ::: "memory");
#pragma unroll
        for (int n = 0; n < 2; ++n) {
            if (n == 1) {
#pragma unroll
                for (int k = 0; k < 3; ++k)
#pragma unroll
                    for (int bj = 0; bj < 2; ++bj) w[k][bj] = *(const f32x4*)(cw + k * 5632 + bj * 2816 + colg + 16);
            }
#pragma unroll
            for (int ai = 0; ai < 2; ++ai) {
                const int pai = wr == 1 ? ai : (ai > 0 ? ai - 1 : 0), pwr = wr ^ 1;
                const int nai = wr == 0 ? ai : (ai < 1 ? ai + 1 : 1), nwr = wr ^ 1;
                f32x4 pvf[2], nxl[2];
#pragma unroll
                for (int bj = 0; bj < 2; ++bj) { pvf[bj] = xl[xi(pai, pwr, 1, wc, bj, n, fq)]; nxl[bj] = xl[xi(nai, nwr, 0, wc, bj, n, fq)]; }
#pragma unroll
                for (int m = 0; m < 4; ++m) {
                    const int row = ai * HALF + wr * 64 + m * 16 + fr;
                    f32x4 cv[2];
#pragma unroll
                    for (int bj = 0; bj < 2; ++bj) {
                        const f32x4 cur = acc[ai][bj][m][n];
                        const f32x4 pr = m > 0 ? acc[ai][bj][m > 0 ? m - 1 : 0][n] : pvf[bj];
                        const f32x4 nr = m < 3 ? acc[ai][bj][m < 3 ? m + 1 : 3][n] : nxl[bj];
                        const f32x4 mixp = fr == 15 ? pr : cur, mixn = fr == 0 ? nr : cur;
                        const f32x4 rp = {dpp_ror1(mixp[0]), dpp_ror1(mixp[1]), dpp_ror1(mixp[2]), dpp_ror1(mixp[3])};
                        const f32x4 rn = {dpp_ror15(mixn[0]), dpp_ror15(mixn[1]), dpp_ror15(mixn[2]), dpp_ror15(mixn[3])};
                        f32x4 c = w[1][bj] * cur;
                        c = rp * w[0][bj] + c;
                        c = rn * w[2][bj] + c;
                        cv[bj] = c;
                    }
                    f32x4 o;
#pragma unroll
                    for (int j = 0; j < 4; ++j) o[j] = cv[0][j] * __builtin_amdgcn_rcpf(1.f + __expf(-cv[0][j])) * cv[1][j];
                    if (row != 0 && row != 255) { u32x2v pk; pk.x = cvt_pk_bf16(o[0], o[1]); pk.y = cvt_pk_bf16(o[2], o[3]);
                        *(u32x2v*)(ACT + (size_t)(u.pm * BM + row) * 2816 + colg + 16 * n) = pk; }
                    if (m & 1) __builtin_amdgcn_sched_barrier(0);
                }
            }
        }
    }
};

template <class Epi, class Sched, bool ALIGN_EPI = false, bool SP2 = false>
__device__ __forceinline__ void gemm_phase(PG8_LAS unsigned char* lds, const Gemm g, const Sched& S, const Epi& E) {
    int tid_ = threadIdx.x; asm volatile("" : "+v"(tid_));
    const int tid = tid_, wid = __builtin_amdgcn_readfirstlane(tid >> 6), lane = tid & 63, wr = wid >> 2, wc = wid & 3, fr = lane & 15, fq = lane >> 4;
    const int K = g.K, nt = K / BK;
    unsigned voffA[2], voffB[2];
#pragma unroll
    for (int i = 0; i < 2; ++i) { int R, C; stage_rc(tid * 16 + i * 8192, R, C); const int Rb = Epi::PERM ? ((R & ~31) + perm32(R & 31)) : R;
        voffA[i] = (unsigned)(R * K + C) * 2u; voffB[i] = (unsigned)(Rb * K + C) * 2u; }
    const size_t kstep = (size_t)(BK * 2);
    const size_t hstep = (size_t)HALF * K * 2;
    const size_t tstep = 2 * hstep;
    const unsigned ldsw = (unsigned)wid * 1024u;
    const int aoff = lds_byte(wr * 64 + fr, fq * 8), boff = lds_byte(wc * 32 + fr, fq * 8);
#define PG8_SA(b, h) (((b) * 2 + (h)) * HTB)
#define PG8_SB(b, h) ((4 + (b) * 2 + (h)) * HTB)
#define PG8_STAGE(bufoff, gbase, voff) do { _Pragma("unroll") for (int _i = 0; _i < 2; ++_i) \
        __builtin_amdgcn_global_load_lds((const unsigned*)((const char*)(gbase) + (voff)[_i]), (PG8_LAS unsigned*)(lds + (bufoff) + ldsw + _i * 8192), 16, 0, 0); } while (0)
#define PG8_LDA(dst, b, h) do { _Pragma("unroll") for (int m = 0; m < 4; ++m) _Pragma("unroll") for (int k = 0; k < 2; ++k) dst[m][k] = *(const PG8_LAS bf16x8*)(lds + PG8_SA(b, h) + aoff + m * 2048 + k * 1024); } while (0)
#define PG8_LDB(dst, b, h) do { _Pragma("unroll") for (int n = 0; n < 2; ++n) _Pragma("unroll") for (int k = 0; k < 2; ++k) dst[n][k] = *(const PG8_LAS bf16x8*)(lds + PG8_SB(b, h) + boff + n * 2048 + k * 1024); } while (0)
#define PG8_MMA(ai, bj, At, Bt) do { __builtin_amdgcn_s_setprio(1); _Pragma("unroll") for (int m = 0; m < 4; ++m) _Pragma("unroll") for (int n = 0; n < 2; ++n) _Pragma("unroll") for (int k = 0; k < 2; ++k) \
        acc[ai][bj][m][n] = __builtin_amdgcn_mfma_f32_16x16x32_bf16(Bt[n][k], At[m][k], acc[ai][bj][m][n], 0, 0, 0); __builtin_amdgcn_s_setprio(0); } while (0)
#define PG8_WAIT_V(n) asm volatile("s_waitcnt vmcnt(" #n ")" ::: "memory")
#define PG8_WAIT_L(n) asm volatile("s_waitcnt lgkmcnt(" #n ")" ::: "memory")
#define PG8_BAR __builtin_amdgcn_s_barrier()
#define PG8_SCHED __builtin_amdgcn_sched_barrier(0)
    Unit cur, nxt; int ui = 0;
    if (!S.next(0, cur)) return;
    f32x4 acc[2][2][4][2];
#pragma unroll
    for (int a = 0; a < 2; ++a)
#pragma unroll
        for (int b = 0; b < 2; ++b)
#pragma unroll
            for (int m = 0; m < 4; ++m)
#pragma unroll
                for (int n = 0; n < 2; ++n) acc[a][b][m][n] = (f32x4){0.f, 0.f, 0.f, 0.f};
    bf16x8 At[4][2], B0[2][2], B1[2][2];
    const char* cA = (const char*)g.A + (size_t)cur.pm * tstep + (size_t)cur.koff * 2; const char* cB = (const char*)g.Bt + (size_t)cur.pn * tstep + (size_t)cur.koff * 2;
    S.a_ready(cur);
    if constexpr (SP2) {
        PG8_STAGE(PG8_SB(0, 0), cB, voffB); PG8_STAGE(PG8_SB(0, 1), cB + hstep, voffB); PG8_STAGE(PG8_SA(0, 0), cA, voffA); PG8_STAGE(PG8_SA(0, 1), cA + hstep, voffA);
        if (wr == 1) PG8_BAR;
        PG8_WAIT_V(2); PG8_BAR;
        PG8_STAGE(PG8_SB(1, 0), cB + kstep, voffB); PG8_STAGE(PG8_SA(1, 0), cA + kstep, voffA); PG8_STAGE(PG8_SB(1, 1), cB + hstep + kstep, voffB);
        PG8_WAIT_V(6); PG8_BAR;
    } else {
        PG8_STAGE(PG8_SB(0, 0), cB, voffB); PG8_STAGE(PG8_SA(0, 0), cA, voffA); PG8_STAGE(PG8_SB(0, 1), cB + hstep, voffB); PG8_STAGE(PG8_SA(0, 1), cA + hstep, voffA);
        if (wr == 1) PG8_BAR;
        PG8_WAIT_V(4); PG8_BAR;
        PG8_STAGE(PG8_SB(1, 0), cB + kstep, voffB); PG8_STAGE(PG8_SA(1, 0), cA + kstep, voffA); PG8_STAGE(PG8_SB(1, 1), cB + hstep + kstep, voffB);
        PG8_WAIT_V(6); PG8_BAR;
    }
    for (;;) {
        const bool has_next = S.next(ui + 1, nxt);
        const char* nA = has_next ? (const char*)g.A + (size_t)nxt.pm * tstep + (size_t)nxt.koff * 2 : cA; const char* nB = has_next ? (const char*)g.Bt + (size_t)nxt.pn * tstep + (size_t)nxt.koff * 2 : cB;
        const int nt_u = cur.nt;
        for (int t = 0; t < nt_u; t += 2) {
            const bool last = (t == nt_u - 2);
            const char* a1 = cA + (size_t)(t + 1) * kstep;
            const char* a2 = last ? nA : cA + (size_t)(t + 2) * kstep; const char* b2 = last ? nB : cB + (size_t)(t + 2) * kstep;
            const char* a3 = a2 + kstep; const char* b3 = b2 + kstep;
            if (last && has_next) S.a_ready(nxt);
            if constexpr (SP2) {
            PG8_LDB(B0, 0, 0); PG8_LDB(B1, 0, 1); PG8_SCHED; PG8_LDA(At, 0, 0); PG8_STAGE(PG8_SA(1, 1), a1 + hstep, voffA);
            PG8_WAIT_V(8); PG8_WAIT_L(0); PG8_BAR; PG8_MMA(0, 0, At, B0); PG8_MMA(0, 1, At, B1); PG8_BAR; PG8_SCHED;
            PG8_LDA(At, 0, 1); PG8_STAGE(PG8_SB(0, 0), b2, voffB); PG8_STAGE(PG8_SB(0, 1), b2 + hstep, voffB); PG8_STAGE(PG8_SA(0, 0), a2, voffA);
            PG8_WAIT_V(8); PG8_WAIT_L(0); PG8_BAR; PG8_MMA(1, 0, At, B0); PG8_MMA(1, 1, At, B1); PG8_BAR; PG8_SCHED;
            PG8_LDB(B0, 1, 0); PG8_LDB(B1, 1, 1); PG8_SCHED; PG8_LDA(At, 1, 0); PG8_STAGE(PG8_SA(0, 1), a2 + hstep, voffA);
            PG8_WAIT_V(8); PG8_WAIT_L(0); PG8_BAR; PG8_MMA(0, 0, At, B0); PG8_MMA(0, 1, At, B1); PG8_BAR; PG8_SCHED;
            PG8_LDA(At, 1, 1); PG8_STAGE(PG8_SB(1, 0), b3, voffB); PG8_STAGE(PG8_SB(1, 1), b3 + hstep, voffB); PG8_STAGE(PG8_SA(1, 0), a3, voffA);
            PG8_WAIT_V(8); PG8_WAIT_L(0); PG8_BAR; PG8_MMA(1, 0, At, B0); PG8_MMA(1, 1, At, B1); PG8_BAR; PG8_SCHED;
            } else {
            PG8_LDB(B0, 0, 0); PG8_SCHED; PG8_LDA(At, 0, 0); PG8_STAGE(PG8_SA(1, 1), a1 + hstep, voffA);
            PG8_WAIT_L(8); PG8_BAR; PG8_WAIT_L(0); PG8_MMA(0, 0, At, B0); PG8_BAR; PG8_SCHED;
            PG8_LDB(B1, 0, 1); PG8_STAGE(PG8_SB(0, 0), b2, voffB);
            PG8_BAR; PG8_WAIT_L(0); PG8_MMA(0, 1, At, B1); PG8_BAR;
            PG8_LDA(At, 0, 1); PG8_STAGE(PG8_SA(0, 0), a2, voffA);
            PG8_BAR; PG8_WAIT_L(0); PG8_MMA(1, 0, At, B0); PG8_BAR; PG8_SCHED;
            PG8_STAGE(PG8_SB(0, 1), b2 + hstep, voffB);
            PG8_WAIT_V(6); PG8_BAR; PG8_MMA(1, 1, At, B1); PG8_BAR;
            PG8_LDB(B0, 1, 0); PG8_SCHED; PG8_LDA(At, 1, 0); PG8_STAGE(PG8_SA(0, 1), a2 + hstep, voffA);
            PG8_WAIT_L(8); PG8_BAR; PG8_WAIT_L(0); PG8_MMA(0, 0, At, B0); PG8_BAR; PG8_SCHED;
            PG8_LDB(B1, 1, 1); PG8_STAGE(PG8_SB(1, 0), b3, voffB);
            PG8_BAR; PG8_WAIT_L(0); PG8_MMA(0, 1, At, B1); PG8_BAR;
            PG8_LDA(At, 1, 1); PG8_STAGE(PG8_SA(1, 0), a3, voffA);
            PG8_BAR; PG8_WAIT_L(0); PG8_MMA(1, 0, At, B0); PG8_BAR; PG8_SCHED;
            PG8_STAGE(PG8_SB(1, 1), b3 + hstep, voffB);
            PG8_WAIT_V(6); PG8_BAR; PG8_MMA(1, 1, At, B1); PG8_BAR;
            }
        }
        if constexpr (ALIGN_EPI) { if (wr == 0) PG8_BAR; }
        if constexpr (!Epi::AFTER_DRAIN) { E(acc, cur, wr, wc, fr, fq); S.done(cur); }
        if (!has_next) break;
#pragma unroll
        for (int a = 0; a < 2; ++a)
#pragma unroll
            for (int b = 0; b < 2; ++b)
#pragma unroll
                for (int m = 0; m < 4; ++m)
#pragma unroll
                    for (int n = 0; n < 2; ++n) acc[a][b][m][n] = (f32x4){0.f, 0.f, 0.f, 0.f};
        cur = nxt; cA = nA; cB = nB; ++ui;
        if constexpr (ALIGN_EPI) { if (wr == 1) PG8_BAR; }
    }
    PG8_WAIT_V(0);
    if constexpr (!ALIGN_EPI) { if (wr == 0) PG8_BAR; }
    PG8_BAR;
    if constexpr (Epi::AFTER_DRAIN) { E.fused(acc, cur, wr, wc, fr, fq, lds, wid, lane); S.done(cur); }
#undef PG8_SA
#undef PG8_SB
#undef PG8_STAGE
#undef PG8_LDA
#undef PG8_LDB
#undef PG8_MMA
#undef PG8_WAIT_V
#undef PG8_WAIT_L
#undef PG8_BAR
#undef PG8_SCHED
}
}

constexpr int DM = 1024, T_P = 32768, T_ALL = 98304, S_P = 2048, S_S = 8192;
constexpr int ZC = 2304;
constexpr int DFF = 2816, UC = 2 * DFF;
constexpr float EPS = 1e-6f;
constexpr int NWAVES = 8;
constexpr int FFN_CHUNK = 32768, N_FFN_CHUNKS = 3;

#define LAS __attribute__((address_space(3)))
typedef unsigned short bf16_t;
typedef short bf16x8 __attribute__((ext_vector_type(8)));
typedef short s16x4 __attribute__((ext_vector_type(4)));
typedef float f32x4 __attribute__((ext_vector_type(4)));
typedef float f32x16 __attribute__((ext_vector_type(16)));
typedef unsigned u32x4 __attribute__((ext_vector_type(4)));
typedef unsigned u32x2 __attribute__((ext_vector_type(2)));

constexpr size_t MiB = 1u << 20;
constexpr size_t WS_MOD = 1 * MiB, WS_COS = 2 * MiB, WS_SIN = 3 * MiB;
constexpr size_t WS_WIN = 4 * MiB, WS_WUQ = 9 * MiB, WS_WUKV = 10 * MiB, WS_WO = 11 * MiB, WS_WUP = 13 * MiB, WS_WDN = 24 * MiB;
constexpr size_t WS_H = 32 * MiB;
constexpr size_t WS_Z = 224 * MiB;
constexpr size_t WS_QB = 224 * MiB, WS_KVB = 368 * MiB;
constexpr size_t WS_CQN = 656 * MiB, WS_CKVN = 728 * MiB, WS_KR = 776 * MiB;
constexpr size_t WS_YC = 788 * MiB;
constexpr size_t WS_ACT = 224 * MiB, WS_UB = 760 * MiB;
constexpr size_t WS_U_UNUSED = 0;
constexpr size_t WS_END = 980 * MiB;

constexpr int LDS_BYTES = 163840;

__device__ __forceinline__ float bf2f(unsigned short u) { return __uint_as_float((unsigned)u << 16); }
__device__ __forceinline__ float bflo(unsigned w) { return __uint_as_float(w << 16); }
__device__ __forceinline__ float bfhi(unsigned w) { return __uint_as_float(w & 0xffff0000u); }
__device__ __forceinline__ unsigned cvtpk(float lo, float hi) { unsigned r; asm volatile("v_cvt_pk_bf16_f32 %0, %1, %2" : "=v"(r) : "v"(lo), "v"(hi)); return r; }
__device__ __forceinline__ float wave_sum(float v) {
#pragma unroll
    for (int o = 1; o < 64; o <<= 1) v += __shfl_xor(v, o);
    return v;
}
__device__ __forceinline__ void unpack8(const u32x4 w, float* f) {
    f[0] = bflo(w.x); f[1] = bfhi(w.x); f[2] = bflo(w.y); f[3] = bfhi(w.y); f[4] = bflo(w.z); f[5] = bfhi(w.z); f[6] = bflo(w.w); f[7] = bfhi(w.w);
}
__device__ __forceinline__ u32x4 pack8(const float* f) {
    u32x4 w; w.x = cvtpk(f[0], f[1]); w.y = cvtpk(f[2], f[3]); w.z = cvtpk(f[4], f[5]); w.w = cvtpk(f[6], f[7]); return w;
}

namespace att {
constexpr float SCALE = 0.07216878364870322f;
constexpr float THR = 8.f;
constexpr float QC = SCALE * 1.4426950408889634f;
constexpr int SHM_V = 16384, SHM_K = 16384, SHM_KR = 8192;
constexpr int OFF_K = 0, OFF_KR = 3 * SHM_K, OFF_V = OFF_KR + 3 * SHM_KR, OFF_WS = OFF_V + 3 * SHM_V, OFF_QR = OFF_WS + 8 * 256, ATT_LDS = OFF_QR + 8 * 4096;
__device__ __forceinline__ void glds16(const void* gsrc, unsigned lds_dst) { unsigned keep;
    asm volatile("s_mov_b32 %0, m0\n\ts_mov_b32 m0, %2\n\ts_nop 0\n\tglobal_load_lds_dwordx4 %1, off\n\ts_mov_b32 m0, %0" : "=&s"(keep) : "v"(gsrc), "s"(lds_dst) : "memory"); }
#define KSWZ(row, colB) ((row) * 256 + ((colB) ^ (((row) & 15) << 4)))
#define KRSWZ(row, colB) ((row) * 128 + ((colB) ^ ((((row) >> 1) & 7) << 4)))
#define SBAR() __builtin_amdgcn_sched_barrier(0)
__device__ __forceinline__ int crow(int r, int hi) { return (r & 3) + 8 * (r >> 2) + 4 * hi; }

__device__ __forceinline__ void partialSM(f32x16& p0, f32x16& p1, float& m_ref, f32x16& negm, float& alpha, bool first) {
    constexpr float THR2 = THR * 1.4426950408889634f;
    float pmax = p0[0];
#pragma unroll
    for (int r = 1; r < 16; ++r) pmax = fmaxf(pmax, p0[r]);
#pragma unroll
    for (int r = 0; r < 16; ++r) pmax = fmaxf(pmax, p1[r]);
    { auto rr = __builtin_amdgcn_permlane32_swap(__float_as_uint(pmax), __float_as_uint(pmax), false, false);
      pmax = fmaxf(__uint_as_float(rr[0]), __uint_as_float(rr[1])); }
    if (__builtin_expect(!first && __all(pmax <= THR2), 1)) { alpha = 1.f; }
    else { const float d = first ? pmax : fmaxf(pmax, 0.f); m_ref += d; alpha = first ? 1.f : __builtin_amdgcn_exp2f(-d);
#pragma unroll
        for (int r = 0; r < 16; ++r) { p0[r] -= d; p1[r] -= d; }
#pragma unroll
        for (int r = 0; r < 16; ++r) negm[r] = -m_ref; }
#pragma unroll
    for (int r = 0; r < 16; ++r) p0[r] = __builtin_amdgcn_exp2f(p0[r]);
}
__device__ __forceinline__ void finishSM(f32x16& p0, f32x16& p1, float alpha, float& l_reg, bf16x8& pa0, bf16x8& pa1, bf16x8& pa2, bf16x8& pa3) {
#pragma unroll
    for (int r = 0; r < 16; ++r) p1[r] = __builtin_amdgcn_exp2f(p1[r]);
    float ps = 0;
#pragma unroll
    for (int r = 0; r < 16; ++r) ps += p0[r];
#pragma unroll
    for (int r = 0; r < 16; ++r) ps += p1[r];
    { auto rr = __builtin_amdgcn_permlane32_swap(__float_as_uint(ps), __float_as_uint(ps), false, false);
      ps = __uint_as_float(rr[0]) + __uint_as_float(rr[1]); }
    l_reg = l_reg * alpha + ps;
#define PK4(P, BASE, OUT) do { unsigned a0 = cvtpk(P[BASE + 0], P[BASE + 1]), a1 = cvtpk(P[BASE + 2], P[BASE + 3]);   \
    unsigned b0 = cvtpk(P[BASE + 4], P[BASE + 5]), b1 = cvtpk(P[BASE + 6], P[BASE + 7]);                              \
    auto r0 = __builtin_amdgcn_permlane32_swap(a0, b0, false, false); auto r1 = __builtin_amdgcn_permlane32_swap(a1, b1, false, false); \
    u32x4 w = {r0[0], r1[0], r0[1], r1[1]}; OUT = *reinterpret_cast<bf16x8*>(&w); } while (0)
    PK4(p0, 0, pa0); PK4(p0, 8, pa1); PK4(p1, 0, pa2); PK4(p1, 8, pa3);
#undef PK4
}
__device__ __forceinline__ void qkt(f32x16& p0, f32x16& p1, const char* Ks, const char* Krs, const bf16x8* qr, const char* qro, int r32, int hi, const f32x16& negm) {
    p0 = negm; p1 = negm;
#pragma unroll
    for (int d0 = 0; d0 < 8; ++d0) { const int cb = (d0 * 16 + hi * 8) * 2;
        const bf16x8 b0 = *reinterpret_cast<const bf16x8*>(Ks + KSWZ(r32, cb));
        const bf16x8 b1 = *reinterpret_cast<const bf16x8*>(Ks + KSWZ(32 + r32, cb));
        p0 = __builtin_amdgcn_mfma_f32_32x32x16_bf16(b0, qr[d0], p0, 0, 0, 0);
        p1 = __builtin_amdgcn_mfma_f32_32x32x16_bf16(b1, qr[d0], p1, 0, 0, 0); }
#pragma unroll
    for (int d0 = 0; d0 < 4; ++d0) { const int cb = (d0 * 16 + hi * 8) * 2;
        const bf16x8 b0 = *reinterpret_cast<const bf16x8*>(Krs + KRSWZ(r32, cb));
        const bf16x8 b1 = *reinterpret_cast<const bf16x8*>(Krs + KRSWZ(32 + r32, cb));
        const bf16x8 qf = qr[8 + d0];
        p0 = __builtin_amdgcn_mfma_f32_32x32x16_bf16(b0, qf, p0, 0, 0, 0);
        p1 = __builtin_amdgcn_mfma_f32_32x32x16_bf16(b1, qf, p1, 0, 0, 0); }
}
__device__ __forceinline__ int v_st(int k, int c) { const int kk = (k & ~0xC) | ((k & 4) << 1) | ((k & 8) >> 1); return ((kk >> 3) * 4 + (c >> 5)) * 512 + ((kk & 7) * 32 + (c & 31)) * 2; }
__device__ __forceinline__ int v_rd_base(int lane) { return ((lane & 3) << 3) | (((lane >> 2) & 3) << 6) | (((lane >> 4) & 1) << 5) | (((lane >> 5) & 1) << 8); }
constexpr int v_rd_off(int d0, int ks, int half) { return d0 * 512 + ks * 4096 + half * 2048; }
template <int OFF> __device__ __forceinline__ s16x4 tr_read(int vb) {
    s16x4 r; asm volatile("ds_read_b64_tr_b16 %0, %1 offset:%2" : "=&v"(r) : "v"(vb), "i"(OFF) : "memory"); return r;
}
template <int D0> __device__ __forceinline__ void pv_one(f32x16& od, int vb, bf16x8 pa0, bf16x8 pa1, bf16x8 pa2, bf16x8 pa3) {
    const s16x4 l0 = tr_read<v_rd_off(D0, 0, 0)>(vb), h0 = tr_read<v_rd_off(D0, 0, 1)>(vb), l1 = tr_read<v_rd_off(D0, 1, 0)>(vb), h1 = tr_read<v_rd_off(D0, 1, 1)>(vb);
    const s16x4 l2 = tr_read<v_rd_off(D0, 2, 0)>(vb), h2 = tr_read<v_rd_off(D0, 2, 1)>(vb), l3 = tr_read<v_rd_off(D0, 3, 0)>(vb), h3 = tr_read<v_rd_off(D0, 3, 1)>(vb);
    asm volatile("s_waitcnt lgkmcnt(0)" ::: "memory"); SBAR();
#define PK(L, H) (bf16x8){L[0], L[1], L[2], L[3], H[0], H[1], H[2], H[3]}
    od = __builtin_amdgcn_mfma_f32_32x32x16_bf16(pa0, PK(l0, h0), od, 0, 0, 0);
    od = __builtin_amdgcn_mfma_f32_32x32x16_bf16(pa1, PK(l1, h1), od, 0, 0, 0);
    od = __builtin_amdgcn_mfma_f32_32x32x16_bf16(pa2, PK(l2, h2), od, 0, 0, 0);
    od = __builtin_amdgcn_mfma_f32_32x32x16_bf16(pa3, PK(l3, h3), od, 0, 0, 0);
#undef PK
}
__device__ __forceinline__ void pv_d0(f32x16* o, int vb, bf16x8 pa0, bf16x8 pa1, bf16x8 pa2, bf16x8 pa3) {
    pv_one<0>(o[0], vb, pa0, pa1, pa2, pa3); pv_one<1>(o[1], vb, pa0, pa1, pa2, pa3); pv_one<2>(o[2], vb, pa0, pa1, pa2, pa3); pv_one<3>(o[3], vb, pa0, pa1, pa2, pa3);
}

__device__ __forceinline__ void attn_unit(const bf16_t* __restrict__ Qb, const bf16_t* __restrict__ Kh, const bf16_t* __restrict__ Vh, const bf16_t* __restrict__ Krh,
                                          bf16_t* __restrict__ Ob, const float* __restrict__ cosq, const float* __restrict__ sinq, int seq, char* lds) {
    int tid_ = threadIdx.x; asm volatile("" : "+v"(tid_));
    const int tid = tid_, wid = tid >> 6, lane = tid & 63, r32 = lane & 31, hi = lane >> 5;
    char* V_lds = lds + OFF_V; char* K_lds = lds + OFF_K; char* Kr_lds = lds + OFF_KR;
    float* ws = (float*)(lds + OFF_WS) + wid * 64; float* li_l = ws; float* al_l = ws + 32;
    float m_reg = 0.f, l_reg = 0; f32x16 negm = {}; f32x16 o[4] = {}; bf16x8 qr[12];
    const char* qro = nullptr;
    const bf16_t* Qw = Qb + (long)(wid * 32 + r32) * 768 + hi * 8;
#pragma unroll
    for (int d0 = 0; d0 < 8; ++d0) { float qf_[8]; unpack8(*reinterpret_cast<const u32x4*>(Qw + d0 * 16), qf_);
#pragma unroll
        for (int j = 0; j < 8; ++j) qf_[j] *= QC;
        qr[d0] = __builtin_bit_cast(bf16x8, pack8(qf_)); }
    {
        const float* cp = cosq + (wid * 32 + r32) * 32 + hi * 8; const float* sp = sinq + (wid * 32 + r32) * 32 + hi * 8;
#pragma unroll
        for (int g = 0; g < 2; ++g) {
            float c[8], s[8], x1[8], x2[8], y1[8], y2[8];
            *(f32x4*)&c[0] = *(const f32x4*)(cp + g * 16); *(f32x4*)&c[4] = *(const f32x4*)(cp + g * 16 + 4);
            *(f32x4*)&s[0] = *(const f32x4*)(sp + g * 16); *(f32x4*)&s[4] = *(const f32x4*)(sp + g * 16 + 4);
            unpack8(*reinterpret_cast<const u32x4*>(Qw + (8 + g) * 16), x1); unpack8(*reinterpret_cast<const u32x4*>(Qw + (10 + g) * 16), x2);
#pragma unroll
            for (int j = 0; j < 8; ++j) { y1[j] = (x1[j] * c[j] - x2[j] * s[j]) * QC; y2[j] = (x2[j] * c[j] + x1[j] * s[j]) * QC; }
            qr[8 + g] = __builtin_bit_cast(bf16x8, pack8(y1)); qr[10 + g] = __builtin_bit_cast(bf16x8, pack8(y2));
        }
    }
    const bf16_t* ksrc[2]; const bf16_t* vsrc[2]; const bf16_t* krsrc;
#pragma unroll
    for (int i = 0; i < 2; ++i) { const int p = (wid * 2 + i) * 64 + lane;
        { const int row = p >> 4, c = (p & 15) ^ (row & 15); ksrc[i] = Kh + (long)row * 1024 + c * 8; }
        { const int s = p >> 5, q = p & 31, kk = (s >> 2) * 8 + (q >> 2), k = (kk & ~0xC) | ((kk & 4) << 1) | ((kk & 8) >> 1), c = (s & 3) * 32 + (q & 3) * 8; vsrc[i] = Vh + (long)k * 1024 + c; } }
    { const int p = wid * 64 + lane, row = p >> 3, c = (p & 7) ^ ((row >> 1) & 7); krsrc = Krh + (long)row * 64 + c * 8; }
    const unsigned lds0 = (unsigned)(uintptr_t)lds;
    const unsigned kdst = lds0 + OFF_K + wid * 2048, krdst = lds0 + OFF_KR + wid * 1024, vdst = lds0 + OFF_V + wid * 2048;
#define DMA_K(t, slot) do { glds16(ksrc[0] + (long)(t) * 65536, (unsigned)__builtin_amdgcn_readfirstlane(kdst + (slot) * SHM_K)); \
    glds16(ksrc[1] + (long)(t) * 65536, (unsigned)__builtin_amdgcn_readfirstlane(kdst + (slot) * SHM_K + 1024)); \
    glds16(krsrc + (long)(t) * 4096, (unsigned)__builtin_amdgcn_readfirstlane(krdst + (slot) * SHM_KR)); } while (0)
#define DMA_V(t, slot) do { glds16(vsrc[0] + (long)(t) * 65536, (unsigned)__builtin_amdgcn_readfirstlane(vdst + (slot) * SHM_V)); \
    glds16(vsrc[1] + (long)(t) * 65536, (unsigned)__builtin_amdgcn_readfirstlane(vdst + (slot) * SHM_V + 1024)); } while (0)
#define WAIT_BAR(N) asm volatile("s_waitcnt vmcnt(" #N ") lgkmcnt(0)\n\ts_barrier" ::: "memory")
    const int vb0 = (int)(uintptr_t)V_lds + v_rd_base(lane);
    const int NT = seq / 64;
#define RESC(a) do { if (__any((a) < 1.f)) { if (hi == 0) al_l[r32] = (a); asm volatile("s_waitcnt lgkmcnt(0)" ::: "memory"); \
    _Pragma("unroll") for (int d = 0; d < 4; ++d) _Pragma("unroll") for (int r = 0; r < 16; ++r) o[d][r] *= al_l[crow(r, hi)]; } } while (0)
    f32x16 p0, p1; float al = 1.f, mn_; bf16x8 pa0, pa1, pa2, pa3;
    asm volatile("s_waitcnt vmcnt(0) lgkmcnt(0)" ::: "memory");
    DMA_K(0, 0); DMA_V(0, 0); DMA_K(1, 1);
    WAIT_BAR(0);
    int s0 = 2, s1 = 0, s2 = 1;
    for (int j = 0; j < NT; ++j) {
        if (j + 1 < NT) DMA_V(j + 1, s2);
        if (j + 2 < NT) DMA_K(j + 2, s0);
        qkt(p0, p1, K_lds + s1 * SHM_K, Kr_lds + s1 * SHM_KR, qr, qro, r32, hi, negm);
        partialSM(p0, p1, m_reg, negm, al, j == 0); finishSM(p0, p1, al, l_reg, pa0, pa1, pa2, pa3);
        RESC(al);
        pv_d0(o, vb0 + s1 * SHM_V, pa0, pa1, pa2, pa3);
        if (j + 2 < NT) { WAIT_BAR(3); } else { WAIT_BAR(0); }
        { const int t_ = s0; s0 = s1; s1 = s2; s2 = t_; }
    }
#undef RESC
#undef DMA_K
#undef DMA_V
#undef WAIT_BAR
    if (hi == 0) li_l[r32] = l_reg; asm volatile("s_waitcnt lgkmcnt(0)" ::: "memory");
    float rli[16];
#pragma unroll
    for (int r = 0; r < 16; ++r) rli[r] = __builtin_amdgcn_rcpf(li_l[crow(r, hi)]);
    bf16_t* Ow = Ob + (long)(wid * 32) * 1024;
#pragma unroll
    for (int r = 0; r < 16; ++r) { const int orow = crow(r, hi);
#pragma unroll
        for (int d0 = 0; d0 < 4; ++d0) Ow[(long)orow * 1024 + d0 * 32 + r32] = (bf16_t)(cvtpk(o[d0][r] * rli[r], 0.f) & 0xffffu); }
    asm volatile("s_waitcnt lgkmcnt(0)" ::: "memory");
}
}

#define GAS __attribute__((address_space(1)))
#define XB_TMO      128
#define XB_XCNT(j)  (256  + 64 * (j))
#define XB_XSUB(j)  (1280 + 64 * (j))
#define XB_XGEN(j)  (2304 + 64 * (j))
#define XB_TOP      3328
#define XB_TOPGEN   3392
#define XCD_BAR_WORDS 3456
#define XB_SPIN_CAP (1u << 18)

__device__ __forceinline__ unsigned xb_ld(unsigned* p)              { return __hip_atomic_load(p, __ATOMIC_RELAXED, __HIP_MEMORY_SCOPE_AGENT); }
__device__ __forceinline__ unsigned xb_add(unsigned* p, unsigned v) { return __hip_atomic_fetch_add(p, v, __ATOMIC_RELAXED, __HIP_MEMORY_SCOPE_AGENT); }
__device__ __forceinline__ unsigned xb_xcc_id() { return (unsigned)__builtin_amdgcn_s_getreg((3 << 11) | 20) & 0xFu; }
#define XB_SPIN(cond, bar) do { unsigned _sp = 0; while (cond) { __builtin_amdgcn_s_sleep(1); \
    if ((++_sp & 255u) == 0u) { if (xb_ld(&(bar)[XB_TMO])) break; if (_sp > XB_SPIN_CAP) { atomicAdd(&(bar)[XB_TMO], 1u); break; } } } } while (0)

struct XcdBarrier {
    unsigned* bar; unsigned x;
    volatile LAS unsigned* st;
};

__device__ __forceinline__ XcdBarrier xcd_barrier_post(unsigned* bar, volatile LAS unsigned* st) {
    XcdBarrier b; b.bar = bar; b.x = xb_xcc_id(); b.st = st;
    if (threadIdx.x == 0) (void)xb_add(&bar[XB_XCNT(b.x)], 1u);
    return b;
}
__device__ __forceinline__ void xcd_barrier_complete(unsigned* bar, unsigned x, unsigned& nloc, unsigned& nx) {
    const unsigned G = gridDim.x * gridDim.y * gridDim.z;
    unsigned sum, cnt, mine, sp = 0u;
    for (;;) {
        sum = 0u; cnt = 0u; mine = 0u;
#pragma unroll
        for (unsigned j = 0; j < 16; ++j) { const unsigned c = xb_ld(&bar[XB_XCNT(j)]); sum += c; cnt += (c > 0u) ? 1u : 0u; mine = (j == x) ? c : mine; }
        if (sum == G) break;
        __builtin_amdgcn_s_sleep(1);
        if ((++sp & 255u) == 0u) { if (xb_ld(&bar[XB_TMO])) break; if (sp > XB_SPIN_CAP) { atomicAdd(&bar[XB_TMO], 1u); break; } }
    }
    nloc = mine > 0u ? mine : 1u; nx = cnt > 0u ? cnt : 1u;
}

__device__ __forceinline__ void xcd_barrier(const XcdBarrier& b) {
    asm volatile("s_waitcnt vmcnt(0)" ::: "memory");
    __syncthreads();
    if (threadIdx.x == 0) {
        unsigned* bar = b.bar;
        __builtin_amdgcn_s_waitcnt(0);
        unsigned nloc = b.st[0], nx = b.st[1];
        if (nloc == 0u) { xcd_barrier_complete(bar, b.x, nloc, nx); b.st[0] = nloc; b.st[1] = nx; }
        const unsigned old = xb_add(&bar[XB_XSUB(b.x)], 1u);
        const unsigned gen = old / nloc;
        if (old + 1u == (gen + 1u) * nloc) {
            __builtin_amdgcn_fence(__ATOMIC_RELEASE, "agent");
            asm volatile("s_waitcnt vmcnt(0)" ::: "memory");
            const unsigned og = xb_add(&bar[XB_TOP], 1u);
            const unsigned tg = og / nx;
            if (og + 1u == (tg + 1u) * nx) xb_add(&bar[XB_TOPGEN], 1u);
            else XB_SPIN(xb_ld(&bar[XB_TOPGEN]) == tg, bar);
            __builtin_amdgcn_fence(__ATOMIC_ACQUIRE, "agent");
            xb_add(&bar[XB_XGEN(b.x)], 1u);
            asm volatile("s_waitcnt vmcnt(0)" ::: "memory");
        } else {
            XB_SPIN(xb_ld(&bar[XB_XGEN(b.x)]) == gen, bar);
            __builtin_amdgcn_fence(__ATOMIC_ACQUIRE, "agent");
            asm volatile("s_waitcnt vmcnt(0)" ::: "memory");
        }
    }
    __syncthreads();
}

struct Args { const float* in[21]; float* out; unsigned char* ws; };

struct Ctx {
    int tid, lane, wave, vcu, G, gw, NGW;
    LAS unsigned char* lds;
};

__device__ __forceinline__ void tok_info(int t, int& bi, int& pos, int& S) {
    if (t < T_P) { bi = t >> 11; pos = t & (S_P - 1); S = S_P; } else { const int u = t - T_P; bi = 16 + (u >> 13); pos = u & (S_S - 1); S = S_S; }
}

template <bool GATE_REMAP = false>
__device__ __forceinline__ void p0_transpose_item(const float* W, int K, int N, bf16_t* WT, LAS float* scr, int item, int lane) {
    const int nblk = N / 32, kb = item / nblk, nb = item % nblk, k0 = 64 * kb, n0 = 32 * nb;
    int nd0 = n0; if (GATE_REMAP) { const int half = n0 / DFF, cc = n0 % DFF; nd0 = (cc / 128) * 256 + half * 128 + (cc % 128); }
#pragma unroll 8
    for (int i = 0; i < 32; ++i) { const int kk = 2 * i + (lane >> 5); scr[kk * 33 + (lane & 31)] = W[(size_t)(k0 + kk) * N + n0 + (lane & 31)]; }
    asm volatile("s_waitcnt lgkmcnt(0)" ::: "memory");
    const int c = lane & 7;
#pragma unroll
    for (int j = 0; j < 4; ++j) { const int n = (lane >> 3) + 8 * j; const LAS float* s = scr + (8 * c) * 33 + n;
        u32x4 o; o.x = cvtpk(s[0 * 33], s[1 * 33]); o.y = cvtpk(s[2 * 33], s[3 * 33]); o.z = cvtpk(s[4 * 33], s[5 * 33]); o.w = cvtpk(s[6 * 33], s[7 * 33]);
        *(u32x4*)(WT + (size_t)(nd0 + n) * K + k0 + 8 * c) = o; }
    asm volatile("s_waitcnt lgkmcnt(0)" ::: "memory");
}

__device__ __forceinline__ void mod_gemv(const Ctx& X, const float* c_p, const float* c_s, const float* w_ada, const float* b_ada, float* mod, int j0) {
    LAS float* cact = (LAS float*)X.lds;
    for (int i = X.tid; i < 24 * 1024; i += 512) { const float c = i < 16 * 1024 ? c_p[i] : c_s[i - 16 * 1024]; cact[i] = c / (1.f + __expf(-c)); }
    __syncthreads();
    float acc[24];
#pragma unroll
    for (int b = 0; b < 24; ++b) acc[b] = 0.f;
    const int kbeg = X.wave * 128;
#pragma unroll 4
    for (int kk = 0; kk < 128; ++kk) { const int k = kbeg + kk; const float wv = w_ada[(size_t)k * 6144 + j0 + X.lane];
#pragma unroll
        for (int b = 0; b < 24; ++b) acc[b] = fmaf(cact[b * 1024 + k], wv, acc[b]); }
    __syncthreads();
    LAS float* red = (LAS float*)X.lds;
#pragma unroll
    for (int b = 0; b < 24; ++b) red[(X.wave * 24 + b) * 64 + X.lane] = acc[b];
    __syncthreads();
    for (int i = X.tid; i < 24 * 64; i += 512) { const int b = i >> 6, l = i & 63; float s = b_ada[j0 + l];
#pragma unroll
        for (int w = 0; w < 8; ++w) s += red[(w * 24 + b) * 64 + l];
        mod[b * 6144 + j0 + l] = s; }
    __syncthreads();
}

__device__ __forceinline__ void modnorm_phase(const Ctx& X, const float* src_p, const float* src_s, const float* g, const float* mod, int sh_off, int sc_off, bf16_t* H) {
    for (int ch = X.gw; ch < T_ALL / 16; ch += X.NGW) {
        const int t0 = ch * 16; int bi, pos, S; tok_info(t0, bi, pos, S);
        const float* src = t0 < T_P ? src_p : src_s;
        const float* mp = mod + bi * 6144;
        f32x4 gs[4], sh[4];
#pragma unroll
        for (int j = 0; j < 4; ++j) { const int c = X.lane * 4 + 256 * j; const f32x4 gg = *(const f32x4*)(g + c), sc = *(const f32x4*)(mp + sc_off + c);
            gs[j] = gg * (sc + 1.0f); sh[j] = *(const f32x4*)(mp + sh_off + c); }
#pragma unroll 2
        for (int r = 0; r < 16; ++r) {
            const float* xr = src + (size_t)(t0 + r) * DM + X.lane * 4;
            f32x4 v[4]; float ss = 0.f;
#pragma unroll
            for (int j = 0; j < 4; ++j) { v[j] = *(const f32x4*)(xr + 256 * j); ss += (v[j].x * v[j].x + v[j].y * v[j].y) + (v[j].z * v[j].z + v[j].w * v[j].w); }
            const float rstd = rsqrtf(wave_sum(ss) * (1.f / DM) + EPS);
            bf16_t* orow = H + (size_t)(t0 + r) * DM + X.lane * 4;
#pragma unroll
            for (int j = 0; j < 4; ++j) { const f32x4 o = v[j] * rstd * gs[j] + sh[j]; u32x2 w; w.x = cvtpk(o.x, o.y); w.y = cvtpk(o.z, o.w); *(u32x2*)(orow + 256 * j) = w; }
        }
    }
}

__device__ __forceinline__ void p3_phase(const Ctx& X, const bf16_t* Z, const float* conv_w, const float* ga, const float* gq, const float* gkv,
                                         const float* cosT, const float* sinT, bf16_t* YC, bf16_t* CQN, bf16_t* CKVN, bf16_t* KR) {
    const int lane = X.lane, c8 = lane * 8;
    float w0[8], w1[8], w2[8], gav[8], gqv[8], gkvv[8];
#pragma unroll
    for (int j = 0; j < 8; ++j) { w0[j] = conv_w[c8 + j]; w1[j] = conv_w[512 + c8 + j]; w2[j] = conv_w[1024 + c8 + j]; gav[j] = ga[c8 + j];
        gqv[j] = lane < 48 ? gq[c8 + j] : 0.f; gkvv[j] = lane < 32 ? gkv[c8 + j] : 0.f; }
    for (int ch = X.gw; ch < T_ALL / 16; ch += X.NGW) {
        const int t0 = ch * 16; int bi, pos0, S; tok_info(t0, bi, pos0, S);
        float prev[8], cur[8], nxt[8];
#define LOADP(dst, t) do { const u32x4 ha_ = *(const u32x4*)(Z + (size_t)(t) * ZC + c8), ca_ = *(const u32x4*)(Z + (size_t)(t) * ZC + 1024 + c8); \
        float hf_[8], cf_[8]; unpack8(ha_, hf_); unpack8(ca_, cf_); _Pragma("unroll") for (int j = 0; j < 8; ++j) dst[j] = hf_[j] * cf_[j]; } while (0)
        if (pos0 == 0) {
#pragma unroll
            for (int j = 0; j < 8; ++j) prev[j] = 0.f;
        } else LOADP(prev, t0 - 1);
        LOADP(cur, t0);
        for (int i = 0; i < 16; ++i) {
            const int t = t0 + i, pos = pos0 + i;
            if (pos == S - 1) {
#pragma unroll
                for (int j = 0; j < 8; ++j) nxt[j] = 0.f;
            } else LOADP(nxt, t + 1);
            const bf16_t* zr = Z + (size_t)t * ZC;
            float bf[8]; unpack8(*(const u32x4*)(zr + 512 + c8), bf);
            float y[8]; float ss_a = 0.f;
#pragma unroll
            for (int j = 0; j < 8; ++j) { y[j] = bf[j] * (w0[j] * prev[j] + w1[j] * cur[j] + w2[j] * nxt[j]); ss_a += y[j] * y[j]; }
            float q[8]; float ss_q = 0.f;
            if (lane < 48) { unpack8(*(const u32x4*)(zr + 1536 + c8), q);
#pragma unroll
                for (int j = 0; j < 8; ++j) ss_q += q[j] * q[j]; }
            float kv[8]; float ss_k = 0.f;
            if (lane < 32) { unpack8(*(const u32x4*)(zr + 1920 + c8), kv);
#pragma unroll
                for (int j = 0; j < 8; ++j) ss_k += kv[j] * kv[j]; }
#pragma unroll
            for (int o = 1; o < 64; o <<= 1) { ss_a += __shfl_xor(ss_a, o); ss_q += __shfl_xor(ss_q, o); ss_k += __shfl_xor(ss_k, o); }
            const float ra = rsqrtf(ss_a * (1.f / 512.f) + EPS), rq = rsqrtf(ss_q * (1.f / 384.f) + EPS), rk = rsqrtf(ss_k * (1.f / 256.f) + EPS);
#pragma unroll
            for (int j = 0; j < 8; ++j) y[j] = y[j] * ra * gav[j];
            *(u32x4*)(YC + (size_t)t * DM + c8) = pack8(y);
            if (lane < 48) {
#pragma unroll
                for (int j = 0; j < 8; ++j) q[j] = q[j] * rq * gqv[j];
                *(u32x4*)(CQN + (size_t)t * 384 + c8) = pack8(q); }
            if (lane < 32) {
#pragma unroll
                for (int j = 0; j < 8; ++j) kv[j] = kv[j] * rk * gkvv[j];
                *(u32x4*)(CKVN + (size_t)t * 256 + c8) = pack8(kv); }
            if (lane < 8) {
                const u32x2 a = *(const u32x2*)(zr + 2176 + lane * 4), b = *(const u32x2*)(zr + 2176 + 32 + lane * 4);
                const f32x4 c = *(const f32x4*)(cosT + pos * 32 + lane * 4), s = *(const f32x4*)(sinT + pos * 32 + lane * 4);
                const f32x4 x1 = {bflo(a.x), bfhi(a.x), bflo(a.y), bfhi(a.y)}, x2 = {bflo(b.x), bfhi(b.x), bflo(b.y), bfhi(b.y)};
                const f32x4 y1 = x1 * c - x2 * s, y2 = x2 * c + x1 * s;
                u32x2 o1, o2; o1.x = cvtpk(y1.x, y1.y); o1.y = cvtpk(y1.z, y1.w); o2.x = cvtpk(y2.x, y2.y); o2.y = cvtpk(y2.z, y2.w);
                *(u32x2*)(KR + (size_t)t * 64 + lane * 4) = o1; *(u32x2*)(KR + (size_t)t * 64 + 32 + lane * 4) = o2;
            }
#pragma unroll
            for (int j = 0; j < 8; ++j) { prev[j] = cur[j]; cur[j] = nxt[j]; }
        }
#undef LOADP
    }
}

__device__ __forceinline__ void p5b_phase(const Ctx& X, bf16_t* YC, const float* gb) {
    const int c8 = X.lane * 8; float g[8];
#pragma unroll
    for (int j = 0; j < 8; ++j) g[j] = gb[c8 + j];
    for (int ch = X.gw; ch < T_ALL / 16; ch += X.NGW) {
#pragma unroll 4
        for (int i = 0; i < 16; ++i) { bf16_t* p = YC + (size_t)(ch * 16 + i) * DM + 512 + c8;
            float v[8]; unpack8(*(const u32x4*)p, v); float ss = 0.f;
#pragma unroll
            for (int j = 0; j < 8; ++j) ss += v[j] * v[j];
            const float r = rsqrtf(wave_sum(ss) * (1.f / 512.f) + EPS);
#pragma unroll
            for (int j = 0; j < 8; ++j) v[j] = v[j] * r * g[j];
            *(u32x4*)p = pack8(v); }
    }
}

__device__ __forceinline__ void p9_fixup_phase(const Ctx& X, const bf16_t* UB, const float* cw, bf16_t* ACT) {
    const int nitems = (T_ALL / 256) * 2 * 6;
    for (int it = X.gw; it < nitems; it += X.NGW) {
        const int cb = it % 6, tb = it / 6, pm = tb >> 1, bot = tb & 1; const int c0 = cb * 512 + X.lane * 8;
        if (c0 >= DFF) continue;
        const int t = pm * 256 + (bot ? 255 : 0); const int S = t < T_P ? S_P : S_S; const int pos = t & (S - 1);
        const u32x4 zero = {0u, 0u, 0u, 0u};
        const bf16_t* r0; const bf16_t* r1; const bf16_t* r2; bool z0 = false, z2 = false;
        if (!bot) { z0 = (pos == 0); r0 = UB + ((size_t)(pm > 0 ? pm - 1 : 0) * 4 + 3) * UC; r1 = UB + ((size_t)pm * 4 + 0) * UC; r2 = UB + ((size_t)pm * 4 + 1) * UC; }
        else { z2 = (pos == S - 1); r0 = UB + ((size_t)pm * 4 + 2) * UC; r1 = UB + ((size_t)pm * 4 + 3) * UC; r2 = UB + ((size_t)(pm < T_ALL / 256 - 1 ? pm + 1 : pm) * 4 + 0) * UC; }
        float o[8], g[8], a[8], b[8], c[8];
        { const u32x4 x0 = z0 ? zero : *(const u32x4*)(r0 + c0), x1 = *(const u32x4*)(r1 + c0), x2 = z2 ? zero : *(const u32x4*)(r2 + c0);
          unpack8(x0, a); unpack8(x1, b); unpack8(x2, c);
#pragma unroll
          for (int j = 0; j < 8; ++j) g[j] = cw[c0 + j] * a[j] + cw[UC + c0 + j] * b[j] + cw[2 * UC + c0 + j] * c[j]; }
        { const u32x4 x0 = z0 ? zero : *(const u32x4*)(r0 + DFF + c0), x1 = *(const u32x4*)(r1 + DFF + c0), x2 = z2 ? zero : *(const u32x4*)(r2 + DFF + c0);
          unpack8(x0, a); unpack8(x1, b); unpack8(x2, c);
#pragma unroll
          for (int j = 0; j < 8; ++j) { const float v = cw[DFF + c0 + j] * a[j] + cw[UC + DFF + c0 + j] * b[j] + cw[2 * UC + DFF + c0 + j] * c[j]; o[j] = g[j] / (1.f + __expf(-g[j])) * v; } }
        *(u32x4*)(ACT + (size_t)t * DFF + c0) = pack8(o);
    }
}

__device__ __forceinline__ void final_norm_phase(const Ctx& X, float* out, const float* g) {
    f32x4 gv[4];
#pragma unroll
    for (int j = 0; j < 4; ++j) gv[j] = *(const f32x4*)(g + X.lane * 4 + 256 * j);
    for (int ch = X.gw; ch < T_ALL / 16; ch += X.NGW) {
#pragma unroll 2
        for (int r = 0; r < 16; ++r) { float* xr = out + (size_t)(ch * 16 + r) * DM + X.lane * 4;
            f32x4 v[4]; float ss = 0.f;
#pragma unroll
            for (int j = 0; j < 4; ++j) { v[j] = *(const f32x4*)(xr + 256 * j); ss += (v[j].x * v[j].x + v[j].y * v[j].y) + (v[j].z * v[j].z + v[j].w * v[j].w); }
            const float rstd = rsqrtf(wave_sum(ss) * (1.f / DM) + EPS);
#pragma unroll
            for (int j = 0; j < 4; ++j) *(f32x4*)(xr + 256 * j) = v[j] * rstd * gv[j]; }
    }
}

__global__ void __launch_bounds__(512, 2) fwd_kernel(Args args) {
    extern __shared__ __attribute__((aligned(16))) unsigned char lds[];
    cg::grid_group grid = cg::this_grid();
    Ctx X; { int t_ = threadIdx.x; asm volatile("" : "+v"(t_)); X.tid = t_; } X.lane = X.tid & 63; X.wave = __builtin_amdgcn_readfirstlane(X.tid >> 6);
    X.G = gridDim.x; { const int bx = blockIdx.x; X.vcu = (X.G % 8 == 0) ? (bx % 8) * (X.G / 8) + bx / 8 : bx; }
    X.gw = X.vcu * NWAVES + X.wave; X.NGW = X.G * NWAVES; X.lds = (LAS unsigned char*)lds;
    unsigned char* ws = args.ws;
    volatile LAS unsigned* bar_st = (volatile LAS unsigned*)(X.lds + (LDS_BYTES - 64));
    if (threadIdx.x < 2) bar_st[threadIdx.x] = 0u;
    __syncthreads();
    XcdBarrier bar = xcd_barrier_post((unsigned*)ws, bar_st);
    const float* x_p = args.in[0]; const float* x_s = args.in[1];
    float* mod = (float*)(ws + WS_MOD); float* cosT = (float*)(ws + WS_COS); float* sinT = (float*)(ws + WS_SIN);
    bf16_t* Win_t = (bf16_t*)(ws + WS_WIN); bf16_t* Wuq_t = (bf16_t*)(ws + WS_WUQ); bf16_t* Wukv_t = (bf16_t*)(ws + WS_WUKV);
    bf16_t* Wo_t = (bf16_t*)(ws + WS_WO); bf16_t* Wup_t = (bf16_t*)(ws + WS_WUP); bf16_t* Wdn_t = (bf16_t*)(ws + WS_WDN);
    bf16_t* H = (bf16_t*)(ws + WS_H); bf16_t* Z = (bf16_t*)(ws + WS_Z); bf16_t* QB = (bf16_t*)(ws + WS_QB); bf16_t* KVB = (bf16_t*)(ws + WS_KVB);
    bf16_t* CQN = (bf16_t*)(ws + WS_CQN); bf16_t* CKVN = (bf16_t*)(ws + WS_CKVN); bf16_t* KR = (bf16_t*)(ws + WS_KR); bf16_t* YC = (bf16_t*)(ws + WS_YC);
    bf16_t* ACT = (bf16_t*)(ws + WS_ACT); bf16_t* UB = (bf16_t*)(ws + WS_UB);
    float* out = args.out;

    {
#ifndef NO_MODGEMV
        if (blockIdx.x < 96) mod_gemv(X, args.in[2], args.in[3], args.in[4], args.in[5], mod, blockIdx.x * 64);
#endif
        LAS float* scr = (LAS float*)(X.lds + X.wave * 16384);
        constexpr int I_IN = 16 * 70, I_UQ = 6 * 24, I_UKV = 4 * 32, I_O = 16 * 32, I_UP = 16 * 176, I_DN = 44 * 32;
        constexpr int NITEMS = I_IN + I_UQ + I_UKV + I_O + I_UP + I_DN;
        for (int it = X.gw; it < NITEMS; it += X.NGW) {
            int r = it;
            if (r < I_IN) { p0_transpose_item(args.in[7], 1024, 2240, Win_t, scr, r, X.lane); continue; } r -= I_IN;
            if (r < I_UQ) { p0_transpose_item(args.in[10], 384, 768, Wuq_t, scr, r, X.lane); continue; } r -= I_UQ;
            if (r < I_UKV) { p0_transpose_item(args.in[12], 256, 1024, Wukv_t, scr, r, X.lane); continue; } r -= I_UKV;
            if (r < I_O) { p0_transpose_item(args.in[15], 1024, 1024, Wo_t, scr, r, X.lane); continue; } r -= I_O;
            if (r < I_UP) { p0_transpose_item<true>(args.in[17], 1024, 5632, Wup_t, scr, r, X.lane); continue; } r -= I_UP;
            p0_transpose_item(args.in[19], 2816, 1024, Wdn_t, scr, r, X.lane);
        }
        { const u32x4 zero = {0u, 0u, 0u, 0u}; u32x4* p = (u32x4*)(Win_t + (size_t)2240 * 1024);
          for (int i = blockIdx.x * 512 + X.tid; i < 64 * 1024 / 8; i += X.G * 512) p[i] = zero; }
        for (int i = blockIdx.x * 512 + X.tid; i < 8192 * 32; i += X.G * 512) {
            const int pos = i >> 5, k = i & 31;
            const double inv = exp2(-(double)k * (13.287712379549449 / 32.0));
            const double rev = (double)pos * inv * 0.15915494309189535;
            const float fr = (float)(rev - floor(rev));
            cosT[i] = __builtin_amdgcn_cosf(fr); sinT[i] = __builtin_amdgcn_sinf(fr);
        }
    }
    grid.sync();
    modnorm_phase(X, x_p, x_s - (size_t)T_P * DM, args.in[6], mod, 0, 1024, H);
    xcd_barrier(bar);
    {
        pg8::Gemm g{H, Win_t, T_ALL, ZC, 1024}; pg8::StaticOrder S; S.init(T_ALL, ZC, X.G, (int)blockIdx.x, 1024);
        pg8::EpiBf16 E{Z, ZC};
#ifndef NO_BF
        pg8::gemm_phase<pg8::EpiBf16, pg8::StaticOrder, true, true>(X.lds, g, S, E);
#endif
    }
    xcd_barrier(bar);
    p3_phase(X, Z, args.in[8], args.in[13], args.in[9], args.in[11], cosT, sinT, YC, CQN, CKVN, KR);
    xcd_barrier(bar);
    {
        pg8::Gemm g{CQN, Wuq_t, T_ALL, 768, 384}; pg8::StaticOrder S; S.init(T_ALL, 768, X.G, (int)blockIdx.x, 384);
        pg8::EpiBf16 E{QB, 768};
#ifndef NO_BF
        pg8::gemm_phase<pg8::EpiBf16, pg8::StaticOrder, true, true>(X.lds, g, S, E);
#endif
    }
    {
        pg8::Gemm g{CKVN, Wukv_t, T_ALL, 1024, 256}; pg8::StaticOrder S; S.init(T_ALL, 1024, X.G, (int)blockIdx.x, 256);
        pg8::EpiBf16 E{KVB, 1024};
#ifndef NO_BF
        pg8::gemm_phase<pg8::EpiBf16, pg8::StaticOrder, true, true>(X.lds, g, S, E);
#endif
    }
    xcd_barrier(bar);
    {
        for (int L = X.vcu; L < 1536; L += X.G) {
            int rowbase, h, q0, seq;
            if (L < 1024) { const int bh = L >> 5, qb = L & 31; rowbase = T_P + (bh >> 2) * S_S; h = bh & 3; q0 = qb * 256; seq = S_S; }
            else { const int l2 = L - 1024; const int bh = l2 >> 3, qb = l2 & 7; rowbase = (bh >> 2) * S_P; h = bh & 3; q0 = qb * 256; seq = S_P; }
#ifndef NO_ATT
            att::attn_unit(QB + (size_t)(rowbase + q0) * 768 + h * 192, KVB + (size_t)rowbase * 1024 + h * 256, KVB + (size_t)rowbase * 1024 + h * 256 + 128,
                           KR + (size_t)rowbase * 64, YC + (size_t)(rowbase + q0) * 1024 + 512 + h * 128, cosT + q0 * 32, sinT + q0 * 32, seq, (char*)lds);
#endif
        }
    }
    xcd_barrier(bar);
    p5b_phase(X, YC, args.in[14]);
    xcd_barrier(bar);
    {
        pg8::Gemm g{YC, Wo_t, T_ALL, 1024, 1024}; pg8::StaticOrder S; S.init(T_ALL, 1024, X.G, (int)blockIdx.x, 1024);
        pg8::EpiRes E{x_p, x_s - (size_t)T_P * DM, out, mod, 2048, 0};
#ifndef NO_RES
        pg8::gemm_phase<pg8::EpiRes, pg8::StaticOrder, true, true>(X.lds, g, S, E);
#endif
    }
    xcd_barrier(bar);
    modnorm_phase(X, out, out, args.in[16], mod, 3072, 4096, H);
    xcd_barrier(bar);
    {
        pg8::Gemm g{H, Wup_t, T_ALL, UC, 1024}; pg8::StaticOrder S; S.init(T_ALL, UC, X.G, (int)blockIdx.x, 1024);
        pg8::EpiGate E{ACT, UB, args.in[18], (LAS pg8::f32x4*)(X.lds + 131072)};
        pg8::gemm_phase<pg8::EpiGate, pg8::StaticOrder, true, true>(X.lds, g, S, E);
    }
    xcd_barrier(bar);
    p9_fixup_phase(X, UB, args.in[18], ACT);
    xcd_barrier(bar);
    {
        pg8::Gemm g{ACT, Wdn_t, T_ALL, 1024, DFF}; pg8::SplitOrder S; S.init(T_ALL, 1024, X.G, (int)blockIdx.x, DFF, (int)((blockIdx.x >> 3) & 1));
        pg8::EpiRes E{out, out, out, mod, 5120, 0};
        pg8::gemm_phase<pg8::EpiRes, pg8::SplitOrder, true, true>(X.lds, g, S, E);
    }
    xcd_barrier(bar);
    final_norm_phase(X, out, args.in[20]);
}

extern "C" void kernel_launch(void* const* d_in, const int* in_sizes, int n_in, void* d_out, int out_size, void* d_ws, size_t ws_size, hipStream_t stream) {
    static int grid = 0;
    if (grid == 0) {
        if (n_in != 21 || out_size != T_ALL * DM || ws_size < WS_END) { fprintf(stderr, "kernel_launch: unexpected shapes: n_in %d out %d ws %zu (need %zu)\n", n_in, out_size, ws_size, (size_t)WS_END); grid = -1; return; }
        int dev = 0, cus = 0, per_cu = 0;
        hipGetDevice(&dev); hipDeviceGetAttribute(&cus, hipDeviceAttributeMultiprocessorCount, dev);
        if (hipFuncSetAttribute((const void*)fwd_kernel, hipFuncAttributeMaxDynamicSharedMemorySize, LDS_BYTES) != hipSuccess) { fprintf(stderr, "kernel_launch: hipFuncSetAttribute failed\n"); grid = -1; return; }
        if (hipOccupancyMaxActiveBlocksPerMultiprocessor(&per_cu, (const void*)fwd_kernel, 512, LDS_BYTES) != hipSuccess || per_cu < 1) { fprintf(stderr, "kernel_launch: occupancy query says %d\n", per_cu); per_cu = 1; }
        (void)hipGetLastError();
        grid = cus * per_cu;
    }
    if (grid < 0) return;
    if (hipMemsetAsync(d_ws, 0, 16384, stream) != hipSuccess) { fprintf(stderr, "kernel_launch: hipMemsetAsync failed\n"); return; }
    Args a{};
    for (int i = 0; i < 21; ++i) a.in[i] = (const float*)d_in[i];
    a.out = (float*)d_out; a.ws = (unsigned char*)d_ws;
    void* kargs[] = {&a};
    hipError_t e = hipLaunchCooperativeKernel((const void*)fwd_kernel, dim3(grid), dim3(512), kargs, LDS_BYTES, stream);
    if (e != hipSuccess) fprintf(stderr, "kernel_launch: cooperative launch failed: %s (grid %d)\n", hipGetErrorString(e), grid);
}
```

```cpp
#include <hip/hip_runtime.h>
#include <hip/hip_cooperative_groups.h>
#include <cstdio>
#include <cstdint>
namespace cg = cooperative_groups;
namespace pg8 {
#define PG8_LAS __attribute__((address_space(3)))
typedef unsigned short bf16_t;
typedef short bf16x8 __attribute__((ext_vector_type(8)));
typedef float f32x4 __attribute__((ext_vector_type(4)));
typedef unsigned u32x4 __attribute__((ext_vector_type(4)));
constexpr int BM = 256, BK = 64, HALF = 128, HTB = HALF * BK * 2  , STAGE_BYTES = 8 * HTB, NXCD = 8, WGM = 8;

__host__ __device__ __forceinline__ int lds_byte(int r, int c) { const int st = (r >> 4) * 2 + (c >> 5), rr = r & 15, cc = c & 31, ob = rr * 64 + cc * 2; return st * 1024 + (ob ^ (((ob >> 9) & 1) << 5)); }
__host__ __device__ __forceinline__ void stage_rc(int b, int& R, int& C) { const int st = b / 1024, sb = b % 1024, swz = sb ^ (((sb >> 9) & 1) << 5); R = (st >> 1) * 16 + swz / 64; C = (st & 1) * 32 + (swz % 64) / 2; }
__host__ __device__ __forceinline__ int perm32(int rho) { const int n = rho >> 4, i = rho & 15; return 8 * (i >> 2) + 4 * n + (i & 3); }

struct Unit { int pm, pn, koff, nt; };
struct Gemm { const bf16_t* A; const bf16_t* Bt; int M, N, K; };

struct StaticOrder {
    int nM, nN, nwg, G, c, ntk;
    __host__ __device__ void init(int M, int N, int G_, int c_, int K_) { nM = M / BM; nN = N / BM; nwg = nM * nN; G = G_; c = c_; ntk = K_ / BK; }
    __host__ __device__ bool next(int i, Unit& u) const {
        const long L = (long)i * G + c; if (L >= nwg) return false;
        int wgid = (int)L; { const int q = nwg / NXCD, r = nwg % NXCD, xcd = wgid % NXCD, off = wgid / NXCD; wgid = (xcd < r ? xcd * (q + 1) : r * (q + 1) + (xcd - r) * q) + off; }
        const int nig = WGM * nN, gid = wgid / nig, fm = gid * WGM, gsz = (nM - fm) < WGM ? (nM - fm) : WGM;
        u.pm = fm + ((wgid % nig) % gsz); u.pn = (wgid % nig) / gsz; u.koff = 0; u.nt = ntk; return true;
    }
    __device__ __forceinline__ void a_ready(const Unit&) const {}
    __device__ __forceinline__ void done(const Unit&) const {}
};

__device__ __forceinline__ unsigned cvt_pk_bf16(float lo, float hi) { unsigned r; asm volatile("v_cvt_pk_bf16_f32 %0, %1, %2" : "=v"(r) : "v"(lo), "v"(hi)); return r; }
typedef float f32x2 __attribute__((ext_vector_type(2)));
struct SplitOrder {
    StaticOrder S; int split, h0;
    __host__ __device__ void init(int M, int N, int G_, int c_, int K_, int split_) { S.init(M, N, G_, c_, K_); split = split_; h0 = ((K_ / BK) / 4) * 2; }
    __host__ __device__ bool next(int i, Unit& u) const {
        if (!split) return S.next(i, u);
        if (i == 0) { if (!S.next(0, u)) return false; u.nt = h0; return true; }
        if (i == 1) { if (!S.next(0, u)) return false; u.koff = h0 * BK; u.nt = S.ntk - h0; return true; }
        return S.next(i - 1, u);
    }
    __device__ __forceinline__ void a_ready(const Unit&) const {}
    __device__ __forceinline__ void done(const Unit&) const {}
};
struct EpiBf16 {
    static constexpr bool PERM = true, AFTER_DRAIN = false;
    bf16_t* O; int ldc;
    __device__ __forceinline__ void operator()(const f32x4 (&acc)[2][2][4][2], const Unit& u, int wr, int wc, int fr, int fq) const {
        const int row0 = u.pm * BM + wr * 64 + fr; const int col0 = u.pn * BM + wc * 32 + 8 * fq;
#pragma unroll
        for (int ai = 0; ai < 2; ++ai)
#pragma unroll
            for (int m = 0; m < 4; ++m) { bf16_t* rowp = O + (size_t)(row0 + ai * HALF + m * 16) * ldc + col0;
#pragma unroll
                for (int bj = 0; bj < 2; ++bj) { const f32x4 v0 = acc[ai][bj][m][0], v1 = acc[ai][bj][m][1];
                    u32x4 w; w.x = cvt_pk_bf16(v0[0], v0[1]); w.y = cvt_pk_bf16(v0[2], v0[3]); w.z = cvt_pk_bf16(v1[0], v1[1]); w.w = cvt_pk_bf16(v1[2], v1[3]);
                    *(u32x4*)(rowp + bj * HALF) = w; } }
    }
};
struct EpiRes {
    static constexpr bool PERM = false, AFTER_DRAIN = false;
    const float* base_p; const float* base_s;
    float* out; const float* mod; int gate_off; int row_off;
    __device__ __forceinline__ void operator()(const f32x4 (&acc)[2][2][4][2], const Unit& u, int wr, int wc, int fr, int fq) const {
        const int t0 = row_off + u.pm * BM;
        const int bi = t0 < 32768 ? (t0 >> 11) : 16 + ((t0 - 32768) >> 13);
        const float* base = t0 < 32768 ? base_p : base_s;
        const float* gp = mod + bi * 6144 + gate_off;
        const int col0 = u.pn * BM + wc * 32 + 4 * fq;
        f32x4 gv[2][2];
#pragma unroll
        for (int bj = 0; bj < 2; ++bj)
#pragma unroll
            for (int n = 0; n < 2; ++n) gv[bj][n] = *(const f32x4*)(gp + col0 + bj * HALF + n * 16);
#pragma unroll
        for (int ai = 0; ai < 2; ++ai)
#pragma unroll
            for (int m = 0; m < 4; ++m) { const size_t off = (size_t)(t0 + ai * HALF + wr * 64 + m * 16 + fr) * 1024 + col0;
#pragma unroll
                for (int bj = 0; bj < 2; ++bj)
#pragma unroll
                    for (int n = 0; n < 2; ++n) { const f32x4 bs = *(const f32x4*)(base + off + bj * HALF + n * 16);
                        *(f32x4*)(out + off + bj * HALF + n * 16) = bs + gv[bj][n] * acc[ai][bj][m][n]; } }
    }
};

__device__ __forceinline__ float dpp_ror1(float x) { return __builtin_bit_cast(float, __builtin_amdgcn_update_dpp(0, __builtin_bit_cast(int, x), 0x121, 0xf, 0xf, false)); }
__device__ __forceinline__ float dpp_ror15(float x) { return __builtin_bit_cast(float, __builtin_amdgcn_update_dpp(0, __builtin_bit_cast(int, x), 0x12F, 0xf, 0xf, false)); }
struct EpiGate {
    static constexpr bool PERM = false, AFTER_DRAIN = false;
    bf16_t* ACT; bf16_t* UB; const float* cw; PG8_LAS f32x4* xl;
    static __device__ __forceinline__ int xi(int ai, int wr, int which, int wc, int bj, int n, int fq) { return (((((ai * 2 + wr) * 2 + which) * 4 + wc) * 2 + bj) * 2 + n) * 4 + fq; }
    __device__ __forceinline__ void operator()(const f32x4 (&acc)[2][2][4][2], const Unit& u, int wr, int wc, int fr, int fq) const {
        typedef unsigned u32x2v __attribute__((ext_vector_type(2)));
        const int colg = u.pn * 128 + wc * 32 + 4 * fq;
        if (fr == 0) {
#pragma unroll
            for (int ai = 0; ai < 2; ++ai)
#pragma unroll
                for (int bj = 0; bj < 2; ++bj)
#pragma unroll
                    for (int n = 0; n < 2; ++n) xl[xi(ai, wr, 0, wc, bj, n, fq)] = acc[ai][bj][0][n];
        }
        if (fr == 15) {
#pragma unroll
            for (int ai = 0; ai < 2; ++ai)
#pragma unroll
                for (int bj = 0; bj < 2; ++bj)
#pragma unroll
                    for (int n = 0; n < 2; ++n) xl[xi(ai, wr, 1, wc, bj, n, fq)] = acc[ai][bj][3][n];
        }
        if (wr == 0 && fr < 2) {
#pragma unroll
            for (int bj = 0; bj < 2; ++bj)
#pragma unroll
                for (int n = 0; n < 2; ++n) { const f32x4 v = acc[0][bj][0][n]; u32x2v w; w.x = cvt_pk_bf16(v[0], v[1]); w.y = cvt_pk_bf16(v[2], v[3]);
                    *(u32x2v*)(UB + ((size_t)u.pm * 4 + fr) * 5632 + bj * 2816 + colg + 16 * n) = w; }
        }
        if (wr == 1 && fr >= 14) {
#pragma unroll
            for (int bj = 0; bj < 2; ++bj)
#pragma unroll
                for (int n = 0; n < 2; ++n) { const f32x4 v = acc[1][bj][3][n]; u32x2v w; w.x = cvt_pk_bf16(v[0], v[1]); w.y = cvt_pk_bf16(v[2], v[3]);
                    *(u32x2v*)(UB + ((size_t)u.pm * 4 + (fr - 12)) * 5632 + bj * 2816 + colg + 16 * n) = w; }
        }
        f32x4 w[3][2];
#pragma unroll
        for (int k = 0; k < 3; ++k)
#pragma unroll
            for (int bj = 0; bj < 2; ++bj) w[k][bj] = *(const f32x4*)(cw + k * 5632 + bj * 2816 + colg);
        asm volatile("s_waitcnt lgkmcnt(0)\n\ts_barrier" ::: "memory");
#pragma unroll
        for (int n = 0; n < 2; ++n) {
            if (n == 1) {
#pragma unroll
                for (int k = 0; k < 3; ++k)
#pragma unroll
                    for (int bj = 0; bj < 2; ++bj) w[k][bj] = *(const f32x4*)(cw + k * 5632 + bj * 2816 + colg + 16);
            }
#pragma unroll
            for (int ai = 0; ai < 2; ++ai) {
                const int pai = wr == 1 ? ai : (ai > 0 ? ai - 1 : 0), pwr = wr ^ 1;
                const int nai = wr == 0 ? ai : (ai < 1 ? ai + 1 : 1), nwr = wr ^ 1;
                f32x4 pvf[2], nxl[2];
#pragma unroll
                for (int bj = 0; bj < 2; ++bj) { pvf[bj] = xl[xi(pai, pwr, 1, wc, bj, n, fq)]; nxl[bj] = xl[xi(nai, nwr, 0, wc, bj, n, fq)]; }
#pragma unroll
                for (int m = 0; m < 4; ++m) {
                    const int row = ai * HALF + wr * 64 + m * 16 + fr;
                    f32x4 cv[2];
#pragma unroll
                    for (int bj = 0; bj < 2; ++bj) {
                        const f32x4 cur = acc[ai][bj][m][n];
                        const f32x4 pr = m > 0 ? acc[ai][bj][m > 0 ? m - 1 : 0][n] : pvf[bj];
                        const f32x4 nr = m < 3 ? acc[ai][bj][m < 3 ? m + 1 : 3][n] : nxl[bj];
                        const f32x4 mixp = fr == 15 ? pr : cur, mixn = fr == 0 ? nr : cur;
                        const f32x4 rp = {dpp_ror1(mixp[0]), dpp_ror1(mixp[1]), dpp_ror1(mixp[2]), dpp_ror1(mixp[3])};
                        const f32x4 rn = {dpp_ror15(mixn[0]), dpp_ror15(mixn[1]), dpp_ror15(mixn[2]), dpp_ror15(mixn[3])};
                        f32x4 c = w[1][bj] * cur;
                        c = rp * w[0][bj] + c;
                        c = rn * w[2][bj] + c;
                        cv[bj] = c;
                    }
                    const f32x4 t = cv[0] * (-1.4426950408889634f);
                    f32x4 d = {__builtin_amdgcn_exp2f(t[0]), __builtin_amdgcn_exp2f(t[1]), __builtin_amdgcn_exp2f(t[2]), __builtin_amdgcn_exp2f(t[3])};
                    d = d + 1.0f;
                    const f32x4 r = {__builtin_amdgcn_rcpf(d[0]), __builtin_amdgcn_rcpf(d[1]), __builtin_amdgcn_rcpf(d[2]), __builtin_amdgcn_rcpf(d[3])};
                    const f32x4 o = (cv[0] * cv[1]) * r;
                    { u32x2v pk; pk.x = cvt_pk_bf16(o[0], o[1]); pk.y = cvt_pk_bf16(o[2], o[3]);
                        *(u32x2v*)(ACT + (size_t)(u.pm * BM + row) * 2816 + colg + 16 * n) = pk; }
                    if (m & 1) __builtin_amdgcn_sched_barrier(0);
                }
            }
        }
    }
};

template <class Epi, class Sched, bool ALIGN_EPI = false, bool SP2 = false>
__device__ __forceinline__ void gemm_phase(PG8_LAS unsigned char* lds, const Gemm g, const Sched& S, const Epi& E) {
    int tid_ = threadIdx.x; asm volatile("" : "+v"(tid_));
    const int tid = tid_, wid = __builtin_amdgcn_readfirstlane(tid >> 6), lane = tid & 63, wr = wid >> 2, wc = wid & 3, fr = lane & 15, fq = lane >> 4;
    const int K = g.K, nt = K / BK;
    unsigned voffA[2], voffB[2];
#pragma unroll
    for (int i = 0; i < 2; ++i) { int R, C; stage_rc(tid * 16 + i * 8192, R, C); const int Rb = Epi::PERM ? ((R & ~31) + perm32(R & 31)) : R;
        voffA[i] = (unsigned)(R * K + C) * 2u; voffB[i] = (unsigned)(Rb * K + C) * 2u; }
    const size_t kstep = (size_t)(BK * 2);
    const size_t hstep = (size_t)HALF * K * 2;
    const size_t tstep = 2 * hstep;
    const unsigned ldsw = (unsigned)wid * 1024u;
    const int aoff = lds_byte(wr * 64 + fr, fq * 8), boff = lds_byte(wc * 32 + fr, fq * 8);
#define PG8_SA(b, h) (((b) * 2 + (h)) * HTB)
#define PG8_SB(b, h) ((4 + (b) * 2 + (h)) * HTB)
#define PG8_STAGE(bufoff, gbase, voff) do { _Pragma("unroll") for (int _i = 0; _i < 2; ++_i) \
        __builtin_amdgcn_global_load_lds((const unsigned*)((const char*)(gbase) + (voff)[_i]), (PG8_LAS unsigned*)(lds + (bufoff) + ldsw + _i * 8192), 16, 0, 0); } while (0)
#define PG8_LDA(dst, b, h) do { _Pragma("unroll") for (int m = 0; m < 4; ++m) _Pragma("unroll") for (int k = 0; k < 2; ++k) dst[m][k] = *(const PG8_LAS bf16x8*)(lds + PG8_SA(b, h) + aoff + m * 2048 + k * 1024); } while (0)
#define PG8_LDB(dst, b, h) do { _Pragma("unroll") for (int n = 0; n < 2; ++n) _Pragma("unroll") for (int k = 0; k < 2; ++k) dst[n][k] = *(const PG8_LAS bf16x8*)(lds + PG8_SB(b, h) + boff + n * 2048 + k * 1024); } while (0)
#define PG8_MMA(ai, bj, At, Bt) do { __builtin_amdgcn_s_setprio(1); _Pragma("unroll") for (int m = 0; m < 4; ++m) _Pragma("unroll") for (int n = 0; n < 2; ++n) _Pragma("unroll") for (int k = 0; k < 2; ++k) \
        acc[ai][bj][m][n] = __builtin_amdgcn_mfma_f32_16x16x32_bf16(Bt[n][k], At[m][k], acc[ai][bj][m][n], 0, 0, 0); __builtin_amdgcn_s_setprio(0); } while (0)
#define PG8_WAIT_V(n) asm volatile("s_waitcnt vmcnt(" #n ")" ::: "memory")
#define PG8_WAIT_L(n) asm volatile("s_waitcnt lgkmcnt(" #n ")" ::: "memory")
#define PG8_BAR __builtin_amdgcn_s_barrier()
#define PG8_SCHED __builtin_amdgcn_sched_barrier(0)
    Unit cur, nxt; int ui = 0;
    if (!S.next(0, cur)) return;
    f32x4 acc[2][2][4][2];
#pragma unroll
    for (int a = 0; a < 2; ++a)
#pragma unroll
        for (int b = 0; b < 2; ++b)
#pragma unroll
            for (int m = 0; m < 4; ++m)
#pragma unroll
                for (int n = 0; n < 2; ++n) acc[a][b][m][n] = (f32x4){0.f, 0.f, 0.f, 0.f};
    bf16x8 At[4][2], B0[2][2], B1[2][2];
    const char* cA = (const char*)g.A + (size_t)cur.pm * tstep + (size_t)cur.koff * 2; const char* cB = (const char*)g.Bt + (size_t)cur.pn * tstep + (size_t)cur.koff * 2;
    S.a_ready(cur);
    if constexpr (SP2) {
        PG8_STAGE(PG8_SB(0, 0), cB, voffB); PG8_STAGE(PG8_SB(0, 1), cB + hstep, voffB); PG8_STAGE(PG8_SA(0, 0), cA, voffA); PG8_STAGE(PG8_SA(0, 1), cA + hstep, voffA);
        if (wr == 1) PG8_BAR;
        PG8_WAIT_V(2); PG8_BAR;
        PG8_STAGE(PG8_SB(1, 0), cB + kstep, voffB); PG8_STAGE(PG8_SA(1, 0), cA + kstep, voffA); PG8_STAGE(PG8_SB(1, 1), cB + hstep + kstep, voffB);
        PG8_WAIT_V(6); PG8_BAR;
    } else {
        PG8_STAGE(PG8_SB(0, 0), cB, voffB); PG8_STAGE(PG8_SA(0, 0), cA, voffA); PG8_STAGE(PG8_SB(0, 1), cB + hstep, voffB); PG8_STAGE(PG8_SA(0, 1), cA + hstep, voffA);
        if (wr == 1) PG8_BAR;
        PG8_WAIT_V(4); PG8_BAR;
        PG8_STAGE(PG8_SB(1, 0), cB + kstep, voffB); PG8_STAGE(PG8_SA(1, 0), cA + kstep, voffA); PG8_STAGE(PG8_SB(1, 1), cB + hstep + kstep, voffB);
        PG8_WAIT_V(6); PG8_BAR;
    }
    for (;;) {
        const bool has_next = S.next(ui + 1, nxt);
        const char* nA = has_next ? (const char*)g.A + (size_t)nxt.pm * tstep + (size_t)nxt.koff * 2 : cA; const char* nB = has_next ? (const char*)g.Bt + (size_t)nxt.pn * tstep + (size_t)nxt.koff * 2 : cB;
        const int nt_u = cur.nt;
        for (int t = 0; t < nt_u; t += 2) {
            const bool last = (t == nt_u - 2);
            const char* a1 = cA + (size_t)(t + 1) * kstep;
            const char* a2 = last ? nA : cA + (size_t)(t + 2) * kstep; const char* b2 = last ? nB : cB + (size_t)(t + 2) * kstep;
            const char* a3 = a2 + kstep; const char* b3 = b2 + kstep;
            if (last && has_next) S.a_ready(nxt);
            if constexpr (SP2) {
            PG8_LDB(B0, 0, 0); PG8_LDB(B1, 0, 1); PG8_SCHED; PG8_LDA(At, 0, 0); PG8_STAGE(PG8_SA(1, 1), a1 + hstep, voffA);
            PG8_WAIT_V(8); PG8_WAIT_L(0); PG8_BAR; PG8_MMA(0, 0, At, B0); PG8_MMA(0, 1, At, B1); PG8_BAR; PG8_SCHED;
            PG8_LDA(At, 0, 1); PG8_STAGE(PG8_SB(0, 0), b2, voffB); PG8_STAGE(PG8_SB(0, 1), b2 + hstep, voffB); PG8_STAGE(PG8_SA(0, 0), a2, voffA);
            PG8_WAIT_V(8); PG8_WAIT_L(0); PG8_BAR; PG8_MMA(1, 0, At, B0); PG8_MMA(1, 1, At, B1); PG8_BAR; PG8_SCHED;
            PG8_LDB(B0, 1, 0); PG8_LDB(B1, 1, 1); PG8_SCHED; PG8_LDA(At, 1, 0); PG8_STAGE(PG8_SA(0, 1), a2 + hstep, voffA);
            PG8_WAIT_V(8); PG8_WAIT_L(0); PG8_BAR; PG8_MMA(0, 0, At, B0); PG8_MMA(0, 1, At, B1); PG8_BAR; PG8_SCHED;
            PG8_LDA(At, 1, 1); PG8_STAGE(PG8_SB(1, 0), b3, voffB); PG8_STAGE(PG8_SB(1, 1), b3 + hstep, voffB); PG8_STAGE(PG8_SA(1, 0), a3, voffA);
            PG8_WAIT_V(8); PG8_WAIT_L(0); PG8_BAR; PG8_MMA(1, 0, At, B0); PG8_MMA(1, 1, At, B1); PG8_BAR; PG8_SCHED;
            } else {
            PG8_LDB(B0, 0, 0); PG8_SCHED; PG8_LDA(At, 0, 0); PG8_STAGE(PG8_SA(1, 1), a1 + hstep, voffA);
            PG8_WAIT_L(8); PG8_BAR; PG8_WAIT_L(0); PG8_MMA(0, 0, At, B0); PG8_BAR; PG8_SCHED;
            PG8_LDB(B1, 0, 1); PG8_STAGE(PG8_SB(0, 0), b2, voffB);
            PG8_BAR; PG8_WAIT_L(0); PG8_MMA(0, 1, At, B1); PG8_BAR;
            PG8_LDA(At, 0, 1); PG8_STAGE(PG8_SA(0, 0), a2, voffA);
            PG8_BAR; PG8_WAIT_L(0); PG8_MMA(1, 0, At, B0); PG8_BAR; PG8_SCHED;
            PG8_STAGE(PG8_SB(0, 1), b2 + hstep, voffB);
            PG8_WAIT_V(6); PG8_BAR; PG8_MMA(1, 1, At, B1); PG8_BAR;
            PG8_LDB(B0, 1, 0); PG8_SCHED; PG8_LDA(At, 1, 0); PG8_STAGE(PG8_SA(0, 1), a2 + hstep, voffA);
            PG8_WAIT_L(8); PG8_BAR; PG8_WAIT_L(0); PG8_MMA(0, 0, At, B0); PG8_BAR; PG8_SCHED;
            PG8_LDB(B1, 1, 1); PG8_STAGE(PG8_SB(1, 0), b3, voffB);
            PG8_BAR; PG8_WAIT_L(0); PG8_MMA(0, 1, At, B1); PG8_BAR;
            PG8_LDA(At, 1, 1); PG8_STAGE(PG8_SA(1, 0), a3, voffA);
            PG8_BAR; PG8_WAIT_L(0); PG8_MMA(1, 0, At, B0); PG8_BAR; PG8_SCHED;
            PG8_STAGE(PG8_SB(1, 1), b3 + hstep, voffB);
            PG8_WAIT_V(6); PG8_BAR; PG8_MMA(1, 1, At, B1); PG8_BAR;
            }
        }
        if constexpr (ALIGN_EPI) { if (wr == 0) PG8_BAR; }
        if constexpr (!Epi::AFTER_DRAIN) { E(acc, cur, wr, wc, fr, fq); S.done(cur); }
        if (!has_next) break;
#pragma unroll
        for (int a = 0; a < 2; ++a)
#pragma unroll
            for (int b = 0; b < 2; ++b)
#pragma unroll
                for (int m = 0; m < 4; ++m)
#pragma unroll
                    for (int n = 0; n < 2; ++n) acc[a][b][m][n] = (f32x4){0.f, 0.f, 0.f, 0.f};
        cur = nxt; cA = nA; cB = nB; ++ui;
        if constexpr (ALIGN_EPI) { if (wr == 1) PG8_BAR; }
    }
    PG8_WAIT_V(0);
    if constexpr (!ALIGN_EPI) { if (wr == 0) PG8_BAR; }
    PG8_BAR;
    if constexpr (Epi::AFTER_DRAIN) { E.fused(acc, cur, wr, wc, fr, fq, lds, wid, lane); S.done(cur); }
#undef PG8_SA
#undef PG8_SB
#undef PG8_STAGE
#undef PG8_LDA
#undef PG8_LDB
#undef PG8_MMA
#undef PG8_WAIT_V
#undef PG8_WAIT_L
#undef PG8_BAR
#undef PG8_SCHED
}
}

constexpr int DM = 1024, T_P = 32768, T_ALL = 98304, S_P = 2048, S_S = 8192;
constexpr int ZC = 2304;
constexpr int DFF = 2816, UC = 2 * DFF;
constexpr float EPS = 1e-6f;
constexpr int NWAVES = 8;
constexpr int FFN_CHUNK = 32768, N_FFN_CHUNKS = 3;

#define LAS __attribute__((address_space(3)))
typedef unsigned short bf16_t;
typedef short bf16x8 __attribute__((ext_vector_type(8)));
typedef short s16x4 __attribute__((ext_vector_type(4)));
typedef float f32x4 __attribute__((ext_vector_type(4)));
typedef float f32x16 __attribute__((ext_vector_type(16)));
typedef unsigned u32x4 __attribute__((ext_vector_type(4)));
typedef unsigned u32x2 __attribute__((ext_vector_type(2)));

constexpr size_t MiB = 1u << 20;
constexpr size_t WS_MOD = 1 * MiB, WS_COS = 2 * MiB, WS_SIN = 3 * MiB;
constexpr size_t WS_WIN = 4 * MiB, WS_WUQ = 9 * MiB, WS_WUKV = 10 * MiB, WS_WO = 11 * MiB, WS_WUP = 13 * MiB, WS_WDN = 24 * MiB;
constexpr size_t WS_H = 32 * MiB;
constexpr size_t WS_Z = 224 * MiB;
constexpr size_t WS_QB = 224 * MiB, WS_KVB = 368 * MiB;
constexpr size_t WS_CQN = 656 * MiB, WS_CKVN = 728 * MiB, WS_KR = 776 * MiB;
constexpr size_t WS_YC = 788 * MiB;
constexpr size_t WS_ACT = 224 * MiB, WS_UB = 760 * MiB;
constexpr size_t WS_U_UNUSED = 0;
constexpr size_t WS_END = 980 * MiB;

constexpr int LDS_BYTES = 163840;

__device__ __forceinline__ float bf2f(unsigned short u) { return __uint_as_float((unsigned)u << 16); }
__device__ __forceinline__ float bflo(unsigned w) { return __uint_as_float(w << 16); }
__device__ __forceinline__ float bfhi(unsigned w) { return __uint_as_float(w & 0xffff0000u); }
__device__ __forceinline__ unsigned cvtpk(float lo, float hi) { unsigned r; asm volatile("v_cvt_pk_bf16_f32 %0, %1, %2" : "=v"(r) : "v"(lo), "v"(hi)); return r; }
__device__ __forceinline__ float wave_sum(float v) {
#pragma unroll
    for (int o = 1; o < 64; o <<= 1) v += __shfl_xor(v, o);
    return v;
}
__device__ __forceinline__ void unpack8(const u32x4 w, float* f) {
    f[0] = bflo(w.x); f[1] = bfhi(w.x); f[2] = bflo(w.y); f[3] = bfhi(w.y); f[4] = bflo(w.z); f[5] = bfhi(w.z); f[6] = bflo(w.w); f[7] = bfhi(w.w);
}
__device__ __forceinline__ u32x4 pack8(const float* f) {
    u32x4 w; w.x = cvtpk(f[0], f[1]); w.y = cvtpk(f[2], f[3]); w.z = cvtpk(f[4], f[5]); w.w = cvtpk(f[6], f[7]); return w;
}

namespace att {
constexpr float SCALE = 0.07216878364870322f;
constexpr float THR = 8.f;
constexpr float QC = SCALE * 1.4426950408889634f;
constexpr int SHM_V = 16384, SHM_K = 16384, SHM_KR = 8192;
constexpr int OFF_K = 0, OFF_KR = 3 * SHM_K, OFF_V = OFF_KR + 3 * SHM_KR, OFF_WS = OFF_V + 3 * SHM_V, OFF_QR = OFF_WS + 8 * 256, ATT_LDS = OFF_QR + 8 * 4096;
__device__ __forceinline__ void glds16(const void* gsrc, unsigned lds_dst) { unsigned keep;
    asm volatile("s_mov_b32 %0, m0\n\ts_mov_b32 m0, %2\n\ts_nop 0\n\tglobal_load_lds_dwordx4 %1, off\n\ts_mov_b32 m0, %0" : "=&s"(keep) : "v"(gsrc), "s"(lds_dst) : "memory"); }
#define KSWZ(row, colB) ((row) * 256 + ((colB) ^ (((row) & 15) << 4)))
#define KRSWZ(row, colB) ((row) * 128 + ((colB) ^ ((((row) >> 1) & 7) << 4)))
#define SBAR() __builtin_amdgcn_sched_barrier(0)
__device__ __forceinline__ int crow(int r, int hi) { return (r & 3) + 8 * (r >> 2) + 4 * hi; }

__device__ __forceinline__ void partialSM(f32x16& p0, f32x16& p1, float& m_ref, f32x16& negm, float& alpha, bool first) {
    constexpr float THR2 = THR * 1.4426950408889634f;
    float pmax = p0[0];
#pragma unroll
    for (int r = 1; r < 16; ++r) pmax = fmaxf(pmax, p0[r]);
#pragma unroll
    for (int r = 0; r < 16; ++r) pmax = fmaxf(pmax, p1[r]);
    { auto rr = __builtin_amdgcn_permlane32_swap(__float_as_uint(pmax), __float_as_uint(pmax), false, false);
      pmax = fmaxf(__uint_as_float(rr[0]), __uint_as_float(rr[1])); }
    if (__builtin_expect(!first && __all(pmax <= THR2), 1)) { alpha = 1.f; }
    else { const float d = first ? pmax : fmaxf(pmax, 0.f); m_ref += d; alpha = first ? 1.f : __builtin_amdgcn_exp2f(-d);
#pragma unroll
        for (int r = 0; r < 16; ++r) { p0[r] -= d; p1[r] -= d; }
#pragma unroll
        for (int r = 0; r < 16; ++r) negm[r] = -m_ref; }
#pragma unroll
    for (int r = 0; r < 16; ++r) p0[r] = __builtin_amdgcn_exp2f(p0[r]);
}
__device__ __forceinline__ void finishSM(f32x16& p0, f32x16& p1, float alpha, float& l_reg, bf16x8& pa0, bf16x8& pa1, bf16x8& pa2, bf16x8& pa3) {
#pragma unroll
    for (int r = 0; r < 16; ++r) p1[r] = __builtin_amdgcn_exp2f(p1[r]);
    float ps = 0;
#pragma unroll
    for (int r = 0; r < 16; ++r) ps += p0[r];
#pragma unroll
    for (int r = 0; r < 16; ++r) ps += p1[r];
    { auto rr = __builtin_amdgcn_permlane32_swap(__float_as_uint(ps), __float_as_uint(ps), false, false);
      ps = __uint_as_float(rr[0]) + __uint_as_float(rr[1]); }
    l_reg = l_reg * alpha + ps;
#define PK4(P, BASE, OUT) do { unsigned a0 = cvtpk(P[BASE + 0], P[BASE + 1]), a1 = cvtpk(P[BASE + 2], P[BASE + 3]);   \
    unsigned b0 = cvtpk(P[BASE + 4], P[BASE + 5]), b1 = cvtpk(P[BASE + 6], P[BASE + 7]);                              \
    auto r0 = __builtin_amdgcn_permlane32_swap(a0, b0, false, false); auto r1 = __builtin_amdgcn_permlane32_swap(a1, b1, false, false); \
    u32x4 w = {r0[0], r1[0], r0[1], r1[1]}; OUT = *reinterpret_cast<bf16x8*>(&w); } while (0)
    PK4(p0, 0, pa0); PK4(p0, 8, pa1); PK4(p1, 0, pa2); PK4(p1, 8, pa3);
#undef PK4
}
__device__ __forceinline__ void qkt(f32x16& p0, f32x16& p1, const char* Ks, const char* Krs, const bf16x8* qr, const char* qro, int r32, int hi, const f32x16& negm) {
    p0 = negm; p1 = negm;
#pragma unroll
    for (int d0 = 0; d0 < 8; ++d0) { const int cb = (d0 * 16 + hi * 8) * 2;
        const bf16x8 b0 = *reinterpret_cast<const bf16x8*>(Ks + KSWZ(r32, cb));
        const bf16x8 b1 = *reinterpret_cast<const bf16x8*>(Ks + KSWZ(32 + r32, cb));
        p0 = __builtin_amdgcn_mfma_f32_32x32x16_bf16(b0, qr[d0], p0, 0, 0, 0);
        p1 = __builtin_amdgcn_mfma_f32_32x32x16_bf16(b1, qr[d0], p1, 0, 0, 0); }
#pragma unroll
    for (int d0 = 0; d0 < 4; ++d0) { const int cb = (d0 * 16 + hi * 8) * 2;
        const bf16x8 b0 = *reinterpret_cast<const bf16x8*>(Krs + KRSWZ(r32, cb));
        const bf16x8 b1 = *reinterpret_cast<const bf16x8*>(Krs + KRSWZ(32 + r32, cb));
        const bf16x8 qf = qr[8 + d0];
        p0 = __builtin_amdgcn_mfma_f32_32x32x16_bf16(b0, qf, p0, 0, 0, 0);
        p1 = __builtin_amdgcn_mfma_f32_32x32x16_bf16(b1, qf, p1, 0, 0, 0); }
}
__device__ __forceinline__ int v_st(int k, int c) { const int kk = (k & ~0xC) | ((k & 4) << 1) | ((k & 8) >> 1); return ((kk >> 3) * 4 + (c >> 5)) * 512 + ((kk & 7) * 32 + (c & 31)) * 2; }
__device__ __forceinline__ int v_rd_base(int lane) { return ((lane & 3) << 3) | (((lane >> 2) & 3) << 6) | (((lane >> 4) & 1) << 5) | (((lane >> 5) & 1) << 8); }
constexpr int v_rd_off(int d0, int ks, int half) { return d0 * 512 + ks * 4096 + half * 2048; }
template <int OFF> __device__ __forceinline__ s16x4 tr_read(int vb) {
    s16x4 r; asm volatile("ds_read_b64_tr_b16 %0, %1 offset:%2" : "=&v"(r) : "v"(vb), "i"(OFF) : "memory"); return r;
}
template <int D0> __device__ __forceinline__ void pv_one(f32x16& od, int vb, bf16x8 pa0, bf16x8 pa1, bf16x8 pa2, bf16x8 pa3) {
    const s16x4 l0 = tr_read<v_rd_off(D0, 0, 0)>(vb), h0 = tr_read<v_rd_off(D0, 0, 1)>(vb), l1 = tr_read<v_rd_off(D0, 1, 0)>(vb), h1 = tr_read<v_rd_off(D0, 1, 1)>(vb);
    const s16x4 l2 = tr_read<v_rd_off(D0, 2, 0)>(vb), h2 = tr_read<v_rd_off(D0, 2, 1)>(vb), l3 = tr_read<v_rd_off(D0, 3, 0)>(vb), h3 = tr_read<v_rd_off(D0, 3, 1)>(vb);
    asm volatile("s_waitcnt lgkmcnt(0)" ::: "memory"); SBAR();
#define PK(L, H) (bf16x8){L[0], L[1], L[2], L[3], H[0], H[1], H[2], H[3]}
    od = __builtin_amdgcn_mfma_f32_32x32x16_bf16(pa0, PK(l0, h0), od, 0, 0, 0);
    od = __builtin_amdgcn_mfma_f32_32x32x16_bf16(pa1, PK(l1, h1), od, 0, 0, 0);
    od = __builtin_amdgcn_mfma_f32_32x32x16_bf16(pa2, PK(l2, h2), od, 0, 0, 0);
    od = __builtin_amdgcn_mfma_f32_32x32x16_bf16(pa3, PK(l3, h3), od, 0, 0, 0);
#undef PK
}
__device__ __forceinline__ void pv_d0(f32x16* o, int vb, bf16x8 pa0, bf16x8 pa1, bf16x8 pa2, bf16x8 pa3) {
    pv_one<0>(o[0], vb, pa0, pa1, pa2, pa3); pv_one<1>(o[1], vb, pa0, pa1, pa2, pa3); pv_one<2>(o[2], vb, pa0, pa1, pa2, pa3); pv_one<3>(o[3], vb, pa0, pa1, pa2, pa3);
}

__device__ __forceinline__ void attn_unit(const bf16_t* __restrict__ Qb, const bf16_t* __restrict__ Kh, const bf16_t* __restrict__ Vh, const bf16_t* __restrict__ Krh,
                                          bf16_t* __restrict__ Ob, const float* __restrict__ cosq, const float* __restrict__ sinq, int seq, char* lds) {
    int tid_ = threadIdx.x; asm volatile("" : "+v"(tid_));
    const int tid = tid_, wid = tid >> 6, lane = tid & 63, r32 = lane & 31, hi = lane >> 5;
    char* V_lds = lds + OFF_V; char* K_lds = lds + OFF_K; char* Kr_lds = lds + OFF_KR;
    float* ws = (float*)(lds + OFF_WS) + wid * 64; float* li_l = ws; float* al_l = ws + 32;
    float m_reg = 0.f, l_reg = 0; f32x16 negm = {}; f32x16 o[4] = {}; bf16x8 qr[12];
    const char* qro = nullptr;
    const bf16_t* Qw = Qb + (long)(wid * 32 + r32) * 768 + hi * 8;
#pragma unroll
    for (int d0 = 0; d0 < 8; ++d0) { float qf_[8]; unpack8(*reinterpret_cast<const u32x4*>(Qw + d0 * 16), qf_);
#pragma unroll
        for (int j = 0; j < 8; ++j) qf_[j] *= QC;
        qr[d0] = __builtin_bit_cast(bf16x8, pack8(qf_)); }
    {
        const float* cp = cosq + (wid * 32 + r32) * 32 + hi * 8; const float* sp = sinq + (wid * 32 + r32) * 32 + hi * 8;
#pragma unroll
        for (int g = 0; g < 2; ++g) {
            float c[8], s[8], x1[8], x2[8], y1[8], y2[8];
            *(f32x4*)&c[0] = *(const f32x4*)(cp + g * 16); *(f32x4*)&c[4] = *(const f32x4*)(cp + g * 16 + 4);
            *(f32x4*)&s[0] = *(const f32x4*)(sp + g * 16); *(f32x4*)&s[4] = *(const f32x4*)(sp + g * 16 + 4);
            unpack8(*reinterpret_cast<const u32x4*>(Qw + (8 + g) * 16), x1); unpack8(*reinterpret_cast<const u32x4*>(Qw + (10 + g) * 16), x2);
#pragma unroll
            for (int j = 0; j < 8; ++j) { y1[j] = (x1[j] * c[j] - x2[j] * s[j]) * QC; y2[j] = (x2[j] * c[j] + x1[j] * s[j]) * QC; }
            qr[8 + g] = __builtin_bit_cast(bf16x8, pack8(y1)); qr[10 + g] = __builtin_bit_cast(bf16x8, pack8(y2));
        }
    }
    const bf16_t* ksrc[2]; const bf16_t* vsrc[2]; const bf16_t* krsrc;
#pragma unroll
    for (int i = 0; i < 2; ++i) { const int p = (wid * 2 + i) * 64 + lane;
        { const int row = p >> 4, c = (p & 15) ^ (row & 15); ksrc[i] = Kh + (long)row * 1024 + c * 8; }
        { const int s = p >> 5, q = p & 31, kk = (s >> 2) * 8 + (q >> 2), k = (kk & ~0xC) | ((kk & 4) << 1) | ((kk & 8) >> 1), c = (s & 3) * 32 + (q & 3) * 8; vsrc[i] = Vh + (long)k * 1024 + c; } }
    { const int p = wid * 64 + lane, row = p >> 3, c = (p & 7) ^ ((row >> 1) & 7); krsrc = Krh + (long)row * 64 + c * 8; }
    const unsigned lds0 = (unsigned)(uintptr_t)lds;
    const unsigned kdst = lds0 + OFF_K + wid * 2048, krdst = lds0 + OFF_KR + wid * 1024, vdst = lds0 + OFF_V + wid * 2048;
#define DMA_K(t, slot) do { glds16(ksrc[0] + (long)(t) * 65536, (unsigned)__builtin_amdgcn_readfirstlane(kdst + (slot) * SHM_K)); \
    glds16(ksrc[1] + (long)(t) * 65536, (unsigned)__builtin_amdgcn_readfirstlane(kdst + (slot) * SHM_K + 1024)); \
    glds16(krsrc + (long)(t) * 4096, (unsigned)__builtin_amdgcn_readfirstlane(krdst + (slot) * SHM_KR)); } while (0)
#define DMA_V(t, slot) do { glds16(vsrc[0] + (long)(t) * 65536, (unsigned)__builtin_amdgcn_readfirstlane(vdst + (slot) * SHM_V)); \
    glds16(vsrc[1] + (long)(t) * 65536, (unsigned)__builtin_amdgcn_readfirstlane(vdst + (slot) * SHM_V + 1024)); } while (0)
#define WAIT_BAR(N) asm volatile("s_waitcnt vmcnt(" #N ") lgkmcnt(0)\n\ts_barrier" ::: "memory")
    const int vb0 = (int)(uintptr_t)V_lds + v_rd_base(lane);
    const int NT = seq / 64;
#define RESC(a) do { if (__any((a) < 1.f)) { if (hi == 0) al_l[r32] = (a); asm volatile("s_waitcnt lgkmcnt(0)" ::: "memory"); \
    _Pragma("unroll") for (int d = 0; d < 4; ++d) _Pragma("unroll") for (int r = 0; r < 16; ++r) o[d][r] *= al_l[crow(r, hi)]; } } while (0)
    f32x16 p0, p1; float al = 1.f, mn_; bf16x8 pa0, pa1, pa2, pa3;
    asm volatile("s_waitcnt vmcnt(0) lgkmcnt(0)" ::: "memory");
    DMA_K(0, 0); DMA_V(0, 0); DMA_K(1, 1);
    WAIT_BAR(0);
    int s0 = 2, s1 = 0, s2 = 1;
    for (int j = 0; j < NT; ++j) {
        if (j + 1 < NT) DMA_V(j + 1, s2);
        if (j + 2 < NT) DMA_K(j + 2, s0);
        qkt(p0, p1, K_lds + s1 * SHM_K, Kr_lds + s1 * SHM_KR, qr, qro, r32, hi, negm);
        partialSM(p0, p1, m_reg, negm, al, j == 0); finishSM(p0, p1, al, l_reg, pa0, pa1, pa2, pa3);
        RESC(al);
        pv_d0(o, vb0 + s1 * SHM_V, pa0, pa1, pa2, pa3);
        if (j + 2 < NT) { WAIT_BAR(3); } else { WAIT_BAR(0); }
        { const int t_ = s0; s0 = s1; s1 = s2; s2 = t_; }
    }
#undef RESC
#undef DMA_K
#undef DMA_V
#undef WAIT_BAR
    if (hi == 0) li_l[r32] = l_reg; asm volatile("s_waitcnt lgkmcnt(0)" ::: "memory");
    float rli[16];
#pragma unroll
    for (int r = 0; r < 16; ++r) rli[r] = __builtin_amdgcn_rcpf(li_l[crow(r, hi)]);
    bf16_t* Ow = Ob + (long)(wid * 32) * 1024;
#pragma unroll
    for (int r = 0; r < 16; ++r) { const int orow = crow(r, hi);
#pragma unroll
        for (int d0 = 0; d0 < 4; ++d0) Ow[(long)orow * 1024 + d0 * 32 + r32] = (bf16_t)(cvtpk(o[d0][r] * rli[r], 0.f) & 0xffffu); }
    asm volatile("s_waitcnt lgkmcnt(0)" ::: "memory");
}
}

#define GAS __attribute__((address_space(1)))
#define XB_TMO      128
#define XB_XCNT(j)  (256  + 64 * (j))
#define XB_XSUB(j)  (1280 + 64 * (j))
#define XB_XGEN(j)  (2304 + 64 * (j))
#define XB_TOP      3328
#define XB_TOPGEN   3392
#define XCD_BAR_WORDS 3456
#define XB_SPIN_CAP (1u << 18)

__device__ __forceinline__ unsigned xb_ld(unsigned* p)              { return __hip_atomic_load(p, __ATOMIC_RELAXED, __HIP_MEMORY_SCOPE_AGENT); }
__device__ __forceinline__ unsigned xb_add(unsigned* p, unsigned v) { return __hip_atomic_fetch_add(p, v, __ATOMIC_RELAXED, __HIP_MEMORY_SCOPE_AGENT); }
__device__ __forceinline__ unsigned xb_xcc_id() { return (unsigned)__builtin_amdgcn_s_getreg((3 << 11) | 20) & 0xFu; }
#define XB_SPIN(cond, bar) do { unsigned _sp = 0; while (cond) { __builtin_amdgcn_s_sleep(1); \
    if ((++_sp & 255u) == 0u) { if (xb_ld(&(bar)[XB_TMO])) break; if (_sp > XB_SPIN_CAP) { atomicAdd(&(bar)[XB_TMO], 1u); break; } } } } while (0)

struct XcdBarrier {
    unsigned* bar; unsigned x;
    volatile LAS unsigned* st;
};

__device__ __forceinline__ XcdBarrier xcd_barrier_post(unsigned* bar, volatile LAS unsigned* st) {
    XcdBarrier b; b.bar = bar; b.x = xb_xcc_id(); b.st = st;
    if (threadIdx.x == 0) (void)xb_add(&bar[XB_XCNT(b.x)], 1u);
    return b;
}
__device__ __forceinline__ void xcd_barrier_complete(unsigned* bar, unsigned x, unsigned& nloc, unsigned& nx) {
    const unsigned G = gridDim.x * gridDim.y * gridDim.z;
    unsigned sum, cnt, mine, sp = 0u;
    for (;;) {
        sum = 0u; cnt = 0u; mine = 0u;
#pragma unroll
        for (unsigned j = 0; j < 16; ++j) { const unsigned c = xb_ld(&bar[XB_XCNT(j)]); sum += c; cnt += (c > 0u) ? 1u : 0u; mine = (j == x) ? c : mine; }
        if (sum == G) break;
        __builtin_amdgcn_s_sleep(1);
        if ((++sp & 255u) == 0u) { if (xb_ld(&bar[XB_TMO])) break; if (sp > XB_SPIN_CAP) { atomicAdd(&bar[XB_TMO], 1u); break; } }
    }
    nloc = mine > 0u ? mine : 1u; nx = cnt > 0u ? cnt : 1u;
}

__device__ __forceinline__ void xcd_barrier(const XcdBarrier& b) {
    asm volatile("s_waitcnt vmcnt(0)" ::: "memory");
    __syncthreads();
    if (threadIdx.x == 0) {
        unsigned* bar = b.bar;
        __builtin_amdgcn_s_waitcnt(0);
        unsigned nloc = b.st[0], nx = b.st[1];
        if (nloc == 0u) { xcd_barrier_complete(bar, b.x, nloc, nx); b.st[0] = nloc; b.st[1] = nx; }
        const unsigned old = xb_add(&bar[XB_XSUB(b.x)], 1u);
        const unsigned gen = old / nloc;
        if (old + 1u == (gen + 1u) * nloc) {
            __builtin_amdgcn_fence(__ATOMIC_RELEASE, "agent");
            asm volatile("s_waitcnt vmcnt(0)" ::: "memory");
            const unsigned og = xb_add(&bar[XB_TOP], 1u);
            const unsigned tg = og / nx;
            if (og + 1u == (tg + 1u) * nx) xb_add(&bar[XB_TOPGEN], 1u);
            else XB_SPIN(xb_ld(&bar[XB_TOPGEN]) == tg, bar);
            __builtin_amdgcn_fence(__ATOMIC_ACQUIRE, "agent");
            xb_add(&bar[XB_XGEN(b.x)], 1u);
            asm volatile("s_waitcnt vmcnt(0)" ::: "memory");
        } else {
            XB_SPIN(xb_ld(&bar[XB_XGEN(b.x)]) == gen, bar);
            __builtin_amdgcn_fence(__ATOMIC_ACQUIRE, "agent");
            asm volatile("s_waitcnt vmcnt(0)" ::: "memory");
        }
    }
    __syncthreads();
}

struct Args { const float* in[21]; float* out; unsigned char* ws; };

struct Ctx {
    int tid, lane, wave, vcu, G, gw, NGW;
    LAS unsigned char* lds;
};

__device__ __forceinline__ void tok_info(int t, int& bi, int& pos, int& S) {
    if (t < T_P) { bi = t >> 11; pos = t & (S_P - 1); S = S_P; } else { const int u = t - T_P; bi = 16 + (u >> 13); pos = u & (S_S - 1); S = S_S; }
}

template <bool GATE_REMAP = false>
__device__ __forceinline__ void p0_transpose_item(const float* W, int K, int N, bf16_t* WT, LAS float* scr, int item, int lane) {
    const int nblk = N / 32, kb = item / nblk, nb = item % nblk, k0 = 64 * kb, n0 = 32 * nb;
    int nd0 = n0; if (GATE_REMAP) { const int half = n0 / DFF, cc = n0 % DFF; nd0 = (cc / 128) * 256 + half * 128 + (cc % 128); }
#pragma unroll 8
    for (int i = 0; i < 32; ++i) { const int kk = 2 * i + (lane >> 5); scr[kk * 33 + (lane & 31)] = W[(size_t)(k0 + kk) * N + n0 + (lane & 31)]; }
    asm volatile("s_waitcnt lgkmcnt(0)" ::: "memory");
    const int c = lane & 7;
#pragma unroll
    for (int j = 0; j < 4; ++j) { const int n = (lane >> 3) + 8 * j; const LAS float* s = scr + (8 * c) * 33 + n;
        u32x4 o; o.x = cvtpk(s[0 * 33], s[1 * 33]); o.y = cvtpk(s[2 * 33], s[3 * 33]); o.z = cvtpk(s[4 * 33], s[5 * 33]); o.w = cvtpk(s[6 * 33], s[7 * 33]);
        *(u32x4*)(WT + (size_t)(nd0 + n) * K + k0 + 8 * c) = o; }
    asm volatile("s_waitcnt lgkmcnt(0)" ::: "memory");
}

__device__ __forceinline__ void mod_gemv(const Ctx& X, const float* c_p, const float* c_s, const float* w_ada, const float* b_ada, float* mod, int j0) {
    LAS float* cact = (LAS float*)X.lds;
    for (int i = X.tid; i < 24 * 1024; i += 512) { const float c = i < 16 * 1024 ? c_p[i] : c_s[i - 16 * 1024]; cact[i] = c / (1.f + __expf(-c)); }
    __syncthreads();
    float acc[24];
#pragma unroll
    for (int b = 0; b < 24; ++b) acc[b] = 0.f;
    const int kbeg = X.wave * 128;
#pragma unroll 4
    for (int kk = 0; kk < 128; ++kk) { const int k = kbeg + kk; const float wv = w_ada[(size_t)k * 6144 + j0 + X.lane];
#pragma unroll
        for (int b = 0; b < 24; ++b) acc[b] = fmaf(cact[b * 1024 + k], wv, acc[b]); }
    __syncthreads();
    LAS float* red = (LAS float*)X.lds;
#pragma unroll
    for (int b = 0; b < 24; ++b) red[(X.wave * 24 + b) * 64 + X.lane] = acc[b];
    __syncthreads();
    for (int i = X.tid; i < 24 * 64; i += 512) { const int b = i >> 6, l = i & 63; float s = b_ada[j0 + l];
#pragma unroll
        for (int w = 0; w < 8; ++w) s += red[(w * 24 + b) * 64 + l];
        mod[b * 6144 + j0 + l] = s; }
    __syncthreads();
}

__device__ __forceinline__ void modnorm_phase(const Ctx& X, const float* src_p, const float* src_s, const float* g, const float* mod, int sh_off, int sc_off, bf16_t* H) {
    for (int ch = X.gw; ch < T_ALL / 16; ch += X.NGW) {
        const int t0 = ch * 16; int bi, pos, S; tok_info(t0, bi, pos, S);
        const float* src = t0 < T_P ? src_p : src_s;
        const float* mp = mod + bi * 6144;
        f32x4 gs[4], sh[4];
#pragma unroll
        for (int j = 0; j < 4; ++j) { const int c = X.lane * 4 + 256 * j; const f32x4 gg = *(const f32x4*)(g + c), sc = *(const f32x4*)(mp + sc_off + c);
            gs[j] = gg * (sc + 1.0f); sh[j] = *(const f32x4*)(mp + sh_off + c); }
#pragma unroll 2
        for (int r = 0; r < 16; ++r) {
            const float* xr = src + (size_t)(t0 + r) * DM + X.lane * 4;
            f32x4 v[4]; float ss = 0.f;
#pragma unroll
            for (int j = 0; j < 4; ++j) { v[j] = *(const f32x4*)(xr + 256 * j); ss += (v[j].x * v[j].x + v[j].y * v[j].y) + (v[j].z * v[j].z + v[j].w * v[j].w); }
            const float rstd = rsqrtf(wave_sum(ss) * (1.f / DM) + EPS);
            bf16_t* orow = H + (size_t)(t0 + r) * DM + X.lane * 4;
#pragma unroll
            for (int j = 0; j < 4; ++j) { const f32x4 o = v[j] * rstd * gs[j] + sh[j]; u32x2 w; w.x = cvtpk(o.x, o.y); w.y = cvtpk(o.z, o.w); *(u32x2*)(orow + 256 * j) = w; }
        }
    }
}

__device__ __forceinline__ void p3_phase(const Ctx& X, const bf16_t* Z, const float* conv_w, const float* ga, const float* gq, const float* gkv,
                                         const float* cosT, const float* sinT, bf16_t* YC, bf16_t* CQN, bf16_t* CKVN, bf16_t* KR) {
    const int lane = X.lane, c8 = lane * 8;
    float w0[8], w1[8], w2[8], gav[8], gqv[8], gkvv[8];
#pragma unroll
    for (int j = 0; j < 8; ++j) { w0[j] = conv_w[c8 + j]; w1[j] = conv_w[512 + c8 + j]; w2[j] = conv_w[1024 + c8 + j]; gav[j] = ga[c8 + j];
        gqv[j] = lane < 48 ? gq[c8 + j] : 0.f; gkvv[j] = lane < 32 ? gkv[c8 + j] : 0.f; }
    for (int ch = X.gw; ch < T_ALL / 16; ch += X.NGW) {
        const int t0 = ch * 16; int bi, pos0, S; tok_info(t0, bi, pos0, S);
        float prev[8], cur[8], nxt[8];
#define LOADP(dst, t) do { const u32x4 ha_ = *(const u32x4*)(Z + (size_t)(t) * ZC + c8), ca_ = *(const u32x4*)(Z + (size_t)(t) * ZC + 1024 + c8); \
        float hf_[8], cf_[8]; unpack8(ha_, hf_); unpack8(ca_, cf_); _Pragma("unroll") for (int j = 0; j < 8; ++j) dst[j] = hf_[j] * cf_[j]; } while (0)
        if (pos0 == 0) {
#pragma unroll
            for (int j = 0; j < 8; ++j) prev[j] = 0.f;
        } else LOADP(prev, t0 - 1);
        LOADP(cur, t0);
        for (int i = 0; i < 16; ++i) {
            const int t = t0 + i, pos = pos0 + i;
            if (pos == S - 1) {
#pragma unroll
                for (int j = 0; j < 8; ++j) nxt[j] = 0.f;
            } else LOADP(nxt, t + 1);
            const bf16_t* zr = Z + (size_t)t * ZC;
            float bf[8]; unpack8(*(const u32x4*)(zr + 512 + c8), bf);
            float y[8]; float ss_a = 0.f;
#pragma unroll
            for (int j = 0; j < 8; ++j) { y[j] = bf[j] * (w0[j] * prev[j] + w1[j] * cur[j] + w2[j] * nxt[j]); ss_a += y[j] * y[j]; }
            float q[8]; float ss_q = 0.f;
            if (lane < 48) { unpack8(*(const u32x4*)(zr + 1536 + c8), q);
#pragma unroll
                for (int j = 0; j < 8; ++j) ss_q += q[j] * q[j]; }
            float kv[8]; float ss_k = 0.f;
            if (lane < 32) { unpack8(*(const u32x4*)(zr + 1920 + c8), kv);
#pragma unroll
                for (int j = 0; j < 8; ++j) ss_k += kv[j] * kv[j]; }
#pragma unroll
            for (int o = 1; o < 64; o <<= 1) { ss_a += __shfl_xor(ss_a, o); ss_q += __shfl_xor(ss_q, o); ss_k += __shfl_xor(ss_k, o); }
            const float ra = rsqrtf(ss_a * (1.f / 512.f) + EPS), rq = rsqrtf(ss_q * (1.f / 384.f) + EPS), rk = rsqrtf(ss_k * (1.f / 256.f) + EPS);
#pragma unroll
            for (int j = 0; j < 8; ++j) y[j] = y[j] * ra * gav[j];
            *(u32x4*)(YC + (size_t)t * DM + c8) = pack8(y);
            if (lane < 48) {
#pragma unroll
                for (int j = 0; j < 8; ++j) q[j] = q[j] * rq * gqv[j];
                *(u32x4*)(CQN + (size_t)t * 384 + c8) = pack8(q); }
            if (lane < 32) {
#pragma unroll
                for (int j = 0; j < 8; ++j) kv[j] = kv[j] * rk * gkvv[j];
                *(u32x4*)(CKVN + (size_t)t * 256 + c8) = pack8(kv); }
            if (lane < 8) {
                const u32x2 a = *(const u32x2*)(zr + 2176 + lane * 4), b = *(const u32x2*)(zr + 2176 + 32 + lane * 4);
                const f32x4 c = *(const f32x4*)(cosT + pos * 32 + lane * 4), s = *(const f32x4*)(sinT + pos * 32 + lane * 4);
                const f32x4 x1 = {bflo(a.x), bfhi(a.x), bflo(a.y), bfhi(a.y)}, x2 = {bflo(b.x), bfhi(b.x), bflo(b.y), bfhi(b.y)};
                const f32x4 y1 = x1 * c - x2 * s, y2 = x2 * c + x1 * s;
                u32x2 o1, o2; o1.x = cvtpk(y1.x, y1.y); o1.y = cvtpk(y1.z, y1.w); o2.x = cvtpk(y2.x, y2.y); o2.y = cvtpk(y2.z, y2.w);
                *(u32x2*)(KR + (size_t)t * 64 + lane * 4) = o1; *(u32x2*)(KR + (size_t)t * 64 + 32 + lane * 4) = o2;
            }
#pragma unroll
            for (int j = 0; j < 8; ++j) { prev[j] = cur[j]; cur[j] = nxt[j]; }
        }
#undef LOADP
    }
}

__device__ __forceinline__ void p5b_phase(const Ctx& X, bf16_t* YC, const float* gb) {
    const int c8 = X.lane * 8; float g[8];
#pragma unroll
    for (int j = 0; j < 8; ++j) g[j] = gb[c8 + j];
    for (int ch = X.gw; ch < T_ALL / 16; ch += X.NGW) {
#pragma unroll 4
        for (int i = 0; i < 16; ++i) { bf16_t* p = YC + (size_t)(ch * 16 + i) * DM + 512 + c8;
            float v[8]; unpack8(*(const u32x4*)p, v); float ss = 0.f;
#pragma unroll
            for (int j = 0; j < 8; ++j) ss += v[j] * v[j];
            const float r = rsqrtf(wave_sum(ss) * (1.f / 512.f) + EPS);
#pragma unroll
            for (int j = 0; j < 8; ++j) v[j] = v[j] * r * g[j];
            *(u32x4*)p = pack8(v); }
    }
}

__device__ __forceinline__ void p9_fixup_phase(const Ctx& X, const bf16_t* UB, const float* cw, bf16_t* ACT) {
    const int nitems = (T_ALL / 256) * 2 * 6;
    for (int it = X.gw; it < nitems; it += X.NGW) {
        const int cb = it % 6, tb = it / 6, pm = tb >> 1, bot = tb & 1; const int c0 = cb * 512 + X.lane * 8;
        if (c0 >= DFF) continue;
        const int t = pm * 256 + (bot ? 255 : 0); const int S = t < T_P ? S_P : S_S; const int pos = t & (S - 1);
        const u32x4 zero = {0u, 0u, 0u, 0u};
        const bf16_t* r0; const bf16_t* r1; const bf16_t* r2; bool z0 = false, z2 = false;
        if (!bot) { z0 = (pos == 0); r0 = UB + ((size_t)(pm > 0 ? pm - 1 : 0) * 4 + 3) * UC; r1 = UB + ((size_t)pm * 4 + 0) * UC; r2 = UB + ((size_t)pm * 4 + 1) * UC; }
        else { z2 = (pos == S - 1); r0 = UB + ((size_t)pm * 4 + 2) * UC; r1 = UB + ((size_t)pm * 4 + 3) * UC; r2 = UB + ((size_t)(pm < T_ALL / 256 - 1 ? pm + 1 : pm) * 4 + 0) * UC; }
        float o[8], g[8], a[8], b[8], c[8];
        { const u32x4 x0 = z0 ? zero : *(const u32x4*)(r0 + c0), x1 = *(const u32x4*)(r1 + c0), x2 = z2 ? zero : *(const u32x4*)(r2 + c0);
          unpack8(x0, a); unpack8(x1, b); unpack8(x2, c);
#pragma unroll
          for (int j = 0; j < 8; ++j) g[j] = cw[c0 + j] * a[j] + cw[UC + c0 + j] * b[j] + cw[2 * UC + c0 + j] * c[j]; }
        { const u32x4 x0 = z0 ? zero : *(const u32x4*)(r0 + DFF + c0), x1 = *(const u32x4*)(r1 + DFF + c0), x2 = z2 ? zero : *(const u32x4*)(r2 + DFF + c0);
          unpack8(x0, a); unpack8(x1, b); unpack8(x2, c);
#pragma unroll
          for (int j = 0; j < 8; ++j) { const float v = cw[DFF + c0 + j] * a[j] + cw[UC + DFF + c0 + j] * b[j] + cw[2 * UC + DFF + c0 + j] * c[j]; o[j] = g[j] / (1.f + __expf(-g[j])) * v; } }
        *(u32x4*)(ACT + (size_t)t * DFF + c0) = pack8(o);
    }
}

__device__ __forceinline__ void final_norm_phase(const Ctx& X, float* out, const float* g) {
    f32x4 gv[4];
#pragma unroll
    for (int j = 0; j < 4; ++j) gv[j] = *(const f32x4*)(g + X.lane * 4 + 256 * j);
    for (int ch = X.gw; ch < T_ALL / 16; ch += X.NGW) {
#pragma unroll 2
        for (int r = 0; r < 16; ++r) { float* xr = out + (size_t)(ch * 16 + r) * DM + X.lane * 4;
            f32x4 v[4]; float ss = 0.f;
#pragma unroll
            for (int j = 0; j < 4; ++j) { v[j] = *(const f32x4*)(xr + 256 * j); ss += (v[j].x * v[j].x + v[j].y * v[j].y) + (v[j].z * v[j].z + v[j].w * v[j].w); }
            const float rstd = rsqrtf(wave_sum(ss) * (1.f / DM) + EPS);
#pragma unroll
            for (int j = 0; j < 4; ++j) *(f32x4*)(xr + 256 * j) = v[j] * rstd * gv[j]; }
    }
}

__global__ void __launch_bounds__(512, 2) fwd_kernel(Args args) {
    extern __shared__ __attribute__((aligned(16))) unsigned char lds[];
    cg::grid_group grid = cg::this_grid();
    Ctx X; { int t_ = threadIdx.x; asm volatile("" : "+v"(t_)); X.tid = t_; } X.lane = X.tid & 63; X.wave = __builtin_amdgcn_readfirstlane(X.tid >> 6);
    X.G = gridDim.x; { const int bx = blockIdx.x; X.vcu = (X.G % 8 == 0) ? (bx % 8) * (X.G / 8) + bx / 8 : bx; }
    X.gw = X.vcu * NWAVES + X.wave; X.NGW = X.G * NWAVES; X.lds = (LAS unsigned char*)lds;
    unsigned char* ws = args.ws;
    volatile LAS unsigned* bar_st = (volatile LAS unsigned*)(X.lds + (LDS_BYTES - 64));
    if (threadIdx.x < 2) bar_st[threadIdx.x] = 0u;
    __syncthreads();
    XcdBarrier bar = xcd_barrier_post((unsigned*)ws, bar_st);
    const float* x_p = args.in[0]; const float* x_s = args.in[1];
    float* mod = (float*)(ws + WS_MOD); float* cosT = (float*)(ws + WS_COS); float* sinT = (float*)(ws + WS_SIN);
    bf16_t* Win_t = (bf16_t*)(ws + WS_WIN); bf16_t* Wuq_t = (bf16_t*)(ws + WS_WUQ); bf16_t* Wukv_t = (bf16_t*)(ws + WS_WUKV);
    bf16_t* Wo_t = (bf16_t*)(ws + WS_WO); bf16_t* Wup_t = (bf16_t*)(ws + WS_WUP); bf16_t* Wdn_t = (bf16_t*)(ws + WS_WDN);
    bf16_t* H = (bf16_t*)(ws + WS_H); bf16_t* Z = (bf16_t*)(ws + WS_Z); bf16_t* QB = (bf16_t*)(ws + WS_QB); bf16_t* KVB = (bf16_t*)(ws + WS_KVB);
    bf16_t* CQN = (bf16_t*)(ws + WS_CQN); bf16_t* CKVN = (bf16_t*)(ws + WS_CKVN); bf16_t* KR = (bf16_t*)(ws + WS_KR); bf16_t* YC = (bf16_t*)(ws + WS_YC);
    bf16_t* ACT = (bf16_t*)(ws + WS_ACT); bf16_t* UB = (bf16_t*)(ws + WS_UB);
    float* out = args.out;

    {
#ifndef NO_MODGEMV
        if (blockIdx.x < 96) mod_gemv(X, args.in[2], args.in[3], args.in[4], args.in[5], mod, blockIdx.x * 64);
#endif
        LAS float* scr = (LAS float*)(X.lds + X.wave * 16384);
        constexpr int I_IN = 16 * 70, I_UQ = 6 * 24, I_UKV = 4 * 32, I_O = 16 * 32, I_UP = 16 * 176, I_DN = 44 * 32;
        constexpr int NITEMS = I_IN + I_UQ + I_UKV + I_O + I_UP + I_DN;
        for (int it = X.gw; it < NITEMS; it += X.NGW) {
            int r = it;
            if (r < I_IN) { p0_transpose_item(args.in[7], 1024, 2240, Win_t, scr, r, X.lane); continue; } r -= I_IN;
            if (r < I_UQ) { p0_transpose_item(args.in[10], 384, 768, Wuq_t, scr, r, X.lane); continue; } r -= I_UQ;
            if (r < I_UKV) { p0_transpose_item(args.in[12], 256, 1024, Wukv_t, scr, r, X.lane); continue; } r -= I_UKV;
            if (r < I_O) { p0_transpose_item(args.in[15], 1024, 1024, Wo_t, scr, r, X.lane); continue; } r -= I_O;
            if (r < I_UP) { p0_transpose_item<true>(args.in[17], 1024, 5632, Wup_t, scr, r, X.lane); continue; } r -= I_UP;
            p0_transpose_item(args.in[19], 2816, 1024, Wdn_t, scr, r, X.lane);
        }
        { const u32x4 zero = {0u, 0u, 0u, 0u}; u32x4* p = (u32x4*)(Win_t + (size_t)2240 * 1024);
          for (int i = blockIdx.x * 512 + X.tid; i < 64 * 1024 / 8; i += X.G * 512) p[i] = zero; }
        for (int i = blockIdx.x * 512 + X.tid; i < 8192 * 32; i += X.G * 512) {
            const int pos = i >> 5, k = i & 31;
            const double inv = exp2(-(double)k * (13.287712379549449 / 32.0));
            const double rev = (double)pos * inv * 0.15915494309189535;
            const float fr = (float)(rev - floor(rev));
            cosT[i] = __builtin_amdgcn_cosf(fr); sinT[i] = __builtin_amdgcn_sinf(fr);
        }
    }
    grid.sync();
    modnorm_phase(X, x_p, x_s - (size_t)T_P * DM, args.in[6], mod, 0, 1024, H);
    xcd_barrier(bar);
    {
        pg8::Gemm g{H, Win_t, T_ALL, ZC, 1024}; pg8::StaticOrder S; S.init(T_ALL, ZC, X.G, (int)blockIdx.x, 1024);
        pg8::EpiBf16 E{Z, ZC};
#ifndef NO_BF
        pg8::gemm_phase<pg8::EpiBf16, pg8::StaticOrder, true, true>(X.lds, g, S, E);
#endif
    }
    xcd_barrier(bar);
    p3_phase(X, Z, args.in[8], args.in[13], args.in[9], args.in[11], cosT, sinT, YC, CQN, CKVN, KR);
    xcd_barrier(bar);
    {
        pg8::Gemm g{CQN, Wuq_t, T_ALL, 768, 384}; pg8::StaticOrder S; S.init(T_ALL, 768, X.G, (int)blockIdx.x, 384);
        pg8::EpiBf16 E{QB, 768};
#ifndef NO_BF
        pg8::gemm_phase<pg8::EpiBf16, pg8::StaticOrder, true, true>(X.lds, g, S, E);
#endif
    }
    {
        pg8::Gemm g{CKVN, Wukv_t, T_ALL, 1024, 256}; pg8::StaticOrder S; S.init(T_ALL, 1024, X.G, (int)blockIdx.x, 256);
        pg8::EpiBf16 E{KVB, 1024};
#ifndef NO_BF
        pg8::gemm_phase<pg8::EpiBf16, pg8::StaticOrder, true, true>(X.lds, g, S, E);
#endif
    }
    xcd_barrier(bar);
    {
        for (int L = X.vcu; L < 1536; L += X.G) {
            int rowbase, h, q0, seq;
            if (L < 1024) { const int bh = L >> 5, qb = L & 31; rowbase = T_P + (bh >> 2) * S_S; h = bh & 3; q0 = qb * 256; seq = S_S; }
            else { const int l2 = L - 1024; const int bh = l2 >> 3, qb = l2 & 7; rowbase = (bh >> 2) * S_P; h = bh & 3; q0 = qb * 256; seq = S_P; }
#ifndef NO_ATT
            att::attn_unit(QB + (size_t)(rowbase + q0) * 768 + h * 192, KVB + (size_t)rowbase * 1024 + h * 256, KVB + (size_t)rowbase * 1024 + h * 256 + 128,
                           KR + (size_t)rowbase * 64, YC + (size_t)(rowbase + q0) * 1024 + 512 + h * 128, cosT + q0 * 32, sinT + q0 * 32, seq, (char*)lds);
#endif
        }
    }
    xcd_barrier(bar);
    p5b_phase(X, YC, args.in[14]);
    xcd_barrier(bar);
    {
        pg8::Gemm g{YC, Wo_t, T_ALL, 1024, 1024}; pg8::StaticOrder S; S.init(T_ALL, 1024, X.G, (int)blockIdx.x, 1024);
        pg8::EpiRes E{x_p, x_s - (size_t)T_P * DM, out, mod, 2048, 0};
#ifndef NO_RES
        pg8::gemm_phase<pg8::EpiRes, pg8::StaticOrder, true, true>(X.lds, g, S, E);
#endif
    }
    xcd_barrier(bar);
    modnorm_phase(X, out, out, args.in[16], mod, 3072, 4096, H);
    xcd_barrier(bar);
    {
        pg8::Gemm g{H, Wup_t, T_ALL, UC, 1024}; pg8::StaticOrder S; S.init(T_ALL, UC, X.G, (int)blockIdx.x, 1024);
        pg8::EpiGate E{ACT, UB, args.in[18], (LAS pg8::f32x4*)(X.lds + 131072)};
        pg8::gemm_phase<pg8::EpiGate, pg8::StaticOrder, true, true>(X.lds, g, S, E);
    }
    xcd_barrier(bar);
    p9_fixup_phase(X, UB, args.in[18], ACT);
    xcd_barrier(bar);
    {
        pg8::Gemm g{ACT, Wdn_t, T_ALL, 1024, DFF}; pg8::SplitOrder S; S.init(T_ALL, 1024, X.G, (int)blockIdx.x, DFF, (int)((blockIdx.x >> 3) & 1));
        pg8::EpiRes E{out, out, out, mod, 5120, 0};
        pg8::gemm_phase<pg8::EpiRes, pg8::SplitOrder, true, true>(X.lds, g, S, E);
    }
    xcd_barrier(bar);
    final_norm_phase(X, out, args.in[20]);
}

extern "C" void kernel_launch(void* const* d_in, const int* in_sizes, int n_in, void* d_out, int out_size, void* d_ws, size_t ws_size, hipStream_t stream) {
    static int grid = 0;
    if (grid == 0) {
        if (n_in != 21 || out_size != T_ALL * DM || ws_size < WS_END) { fprintf(stderr, "kernel_launch: unexpected shapes: n_in %d out %d ws %zu (need %zu)\n", n_in, out_size, ws_size, (size_t)WS_END); grid = -1; return; }
        int dev = 0, cus = 0, per_cu = 0;
        hipGetDevice(&dev); hipDeviceGetAttribute(&cus, hipDeviceAttributeMultiprocessorCount, dev);
        if (hipFuncSetAttribute((const void*)fwd_kernel, hipFuncAttributeMaxDynamicSharedMemorySize, LDS_BYTES) != hipSuccess) { fprintf(stderr, "kernel_launch: hipFuncSetAttribute failed\n"); grid = -1; return; }
        if (hipOccupancyMaxActiveBlocksPerMultiprocessor(&per_cu, (const void*)fwd_kernel, 512, LDS_BYTES) != hipSuccess || per_cu < 1) { fprintf(stderr, "kernel_launch: occupancy query says %d\n", per_cu); per_cu = 1; }
        (void)hipGetLastError();
        grid = cus * per_cu;
    }
    if (grid < 0) return;
    if (hipMemsetAsync(d_ws, 0, 16384, stream) != hipSuccess) { fprintf(stderr, "kernel_launch: hipMemsetAsync failed\n"); return; }
    Args a{};
    for (int i = 0; i < 21; ++i) a.in[i] = (const float*)d_in[i];
    a.out = (float*)d_out; a.ws = (unsigned char*)d_ws;
    void* kargs[] = {&a};
    hipError_t e = hipLaunchCooperativeKernel((const void*)fwd_kernel, dim3(grid), dim3(512), kargs, LDS_BYTES, stream);
    if (e != hipSuccess) fprintf(stderr, "kernel_launch: cooperative launch failed: %s (grid %d)\n", hipGetErrorString(e), grid);
}
```

```cpp
#include <hip/hip_runtime.h>
#include <hip/hip_cooperative_groups.h>
#include <cstdio>
#include <cstdint>
namespace cg = cooperative_groups;
namespace pg8 {
#define PG8_LAS __attribute__((address_space(3)))
typedef unsigned short bf16_t;
typedef short bf16x8 __attribute__((ext_vector_type(8)));
typedef float f32x4 __attribute__((ext_vector_type(4)));
typedef unsigned u32x4 __attribute__((ext_vector_type(4)));
constexpr int BM = 256, BK = 64, HALF = 128, HTB = HALF * BK * 2  , STAGE_BYTES = 8 * HTB, NXCD = 8, WGM = 8;

__host__ __device__ __forceinline__ int lds_byte(int r, int c) { const int st = (r >> 4) * 2 + (c >> 5), rr = r & 15, cc = c & 31, ob = rr * 64 + cc * 2; return st * 1024 + (ob ^ (((ob >> 9) & 1) << 5)); }
__host__ __device__ __forceinline__ void stage_rc(int b, int& R, int& C) { const int st = b / 1024, sb = b % 1024, swz = sb ^ (((sb >> 9) & 1) << 5); R = (st >> 1) * 16 + swz / 64; C = (st & 1) * 32 + (swz % 64) / 2; }
__host__ __device__ __forceinline__ int perm32(int rho) { const int n = rho >> 4, i = rho & 15; return 8 * (i >> 2) + 4 * n + (i & 3); }

struct Unit { int pm, pn, koff, nt; };
struct Gemm { const bf16_t* A; const bf16_t* Bt; int M, N, K; };

struct StaticOrder {
    int nM, nN, nwg, G, c, ntk;
    __host__ __device__ void init(int M, int N, int G_, int c_, int K_) { nM = M / BM; nN = N / BM; nwg = nM * nN; G = G_; c = c_; ntk = K_ / BK; }
    __host__ __device__ bool next(int i, Unit& u) const {
        const long L = (long)i * G + c; if (L >= nwg) return false;
        int wgid = (int)L; { const int q = nwg / NXCD, r = nwg % NXCD, xcd = wgid % NXCD, off = wgid / NXCD; wgid = (xcd < r ? xcd * (q + 1) : r * (q + 1) + (xcd - r) * q) + off; }
        const int nig = WGM * nN, gid = wgid / nig, fm = gid * WGM, gsz = (nM - fm) < WGM ? (nM - fm) : WGM;
        u.pm = fm + ((wgid % nig) % gsz); u.pn = (wgid % nig) / gsz; u.koff = 0; u.nt = ntk; return true;
    }
    __device__ __forceinline__ void a_ready(const Unit&) const {}
    __device__ __forceinline__ void done(const Unit&) const {}
};

__device__ __forceinline__ unsigned cvt_pk_bf16(float lo, float hi) { unsigned r; asm volatile("v_cvt_pk_bf16_f32 %0, %1, %2" : "=v"(r) : "v"(lo), "v"(hi)); return r; }
typedef float f32x2 __attribute__((ext_vector_type(2)));
struct SplitOrder {
    StaticOrder S; int split, h0;
    __host__ __device__ void init(int M, int N, int G_, int c_, int K_, int split_) { S.init(M, N, G_, c_, K_); split = split_; h0 = ((K_ / BK) / 4) * 2; }
    __host__ __device__ bool next(int i, Unit& u) const {
        if (!split) return S.next(i, u);
        if (i == 0) { if (!S.next(0, u)) return false; u.nt = h0; return true; }
        if (i == 1) { if (!S.next(0, u)) return false; u.koff = h0 * BK; u.nt = S.ntk - h0; return true; }
        return S.next(i - 1, u);
    }
    __device__ __forceinline__ void a_ready(const Unit&) const {}
    __device__ __forceinline__ void done(const Unit&) const {}
};
struct EpiBf16 {
    static constexpr bool PERM = true, AFTER_DRAIN = false;
    bf16_t* O; int ldc;
    __device__ __forceinline__ void operator()(const f32x4 (&acc)[2][2][4][2], const Unit& u, int wr, int wc, int fr, int fq) const {
        const int row0 = u.pm * BM + wr * 64 + fr; const int col0 = u.pn * BM + wc * 32 + 8 * fq;
#pragma unroll
        for (int ai = 0; ai < 2; ++ai)
#pragma unroll
            for (int m = 0; m < 4; ++m) { bf16_t* rowp = O + (size_t)(row0 + ai * HALF + m * 16) * ldc + col0;
#pragma unroll
                for (int bj = 0; bj < 2; ++bj) { const f32x4 v0 = acc[ai][bj][m][0], v1 = acc[ai][bj][m][1];
                    u32x4 w; w.x = cvt_pk_bf16(v0[0], v0[1]); w.y = cvt_pk_bf16(v0[2], v0[3]); w.z = cvt_pk_bf16(v1[0], v1[1]); w.w = cvt_pk_bf16(v1[2], v1[3]);
                    *(u32x4*)(rowp + bj * HALF) = w; } }
    }
};
struct EpiRes {
    static constexpr bool PERM = false, AFTER_DRAIN = false;
    const float* base_p; const float* base_s;
    float* out; const float* mod; int gate_off; int row_off;
    __device__ __forceinline__ void operator()(const f32x4 (&acc)[2][2][4][2], const Unit& u, int wr, int wc, int fr, int fq) const {
        const int t0 = row_off + u.pm * BM;
        const int bi = t0 < 32768 ? (t0 >> 11) : 16 + ((t0 - 32768) >> 13);
        const float* base = t0 < 32768 ? base_p : base_s;
        const float* gp = mod + bi * 6144 + gate_off;
        const int col0 = u.pn * BM + wc * 32 + 4 * fq;
        f32x4 gv[2][2];
#pragma unroll
        for (int bj = 0; bj < 2; ++bj)
#pragma unroll
            for (int n = 0; n < 2; ++n) gv[bj][n] = *(const f32x4*)(gp + col0 + bj * HALF + n * 16);
#pragma unroll
        for (int ai = 0; ai < 2; ++ai)
#pragma unroll
            for (int m = 0; m < 4; ++m) { const size_t off = (size_t)(t0 + ai * HALF + wr * 64 + m * 16 + fr) * 1024 + col0;
#pragma unroll
                for (int bj = 0; bj < 2; ++bj)
#pragma unroll
                    for (int n = 0; n < 2; ++n) { const f32x4 bs = *(const f32x4*)(base + off + bj * HALF + n * 16);
                        *(f32x4*)(out + off + bj * HALF + n * 16) = bs + gv[bj][n] * acc[ai][bj][m][n]; } }
    }
};

__device__ __forceinline__ float dpp_ror1(float x) { return __builtin_bit_cast(float, __builtin_amdgcn_update_dpp(0, __builtin_bit_cast(int, x), 0x121, 0xf, 0xf, false)); }
__device__ __forceinline__ float dpp_ror15(float x) { return __builtin_bit_cast(float, __builtin_amdgcn_update_dpp(0, __builtin_bit_cast(int, x), 0x12F, 0xf, 0xf, false)); }
struct EpiGate {
    static constexpr bool PERM = false, AFTER_DRAIN = false;
    bf16_t* ACT; bf16_t* UB; const float* cw; PG8_LAS f32x4* xl;
    static __device__ __forceinline__ int xi(int ai, int wr, int which, int wc, int bj, int n, int fq) { return (((((ai * 2 + wr) * 2 + which) * 4 + wc) * 2 + bj) * 2 + n) * 4 + fq; }
    __device__ __forceinline__ void operator()(const f32x4 (&acc)[2][2][4][2], const Unit& u, int wr, int wc, int fr, int fq) const {
        typedef unsigned u32x2v __attribute__((ext_vector_type(2)));
        const int colg = u.pn * 128 + wc * 32 + 4 * fq;
        if (fr == 0) {
#pragma unroll
            for (int ai = 0; ai < 2; ++ai)
#pragma unroll
                for (int bj = 0; bj < 2; ++bj)
#pragma unroll
                    for (int n = 0; n < 2; ++n) xl[xi(ai, wr, 0, wc, bj, n, fq)] = acc[ai][bj][0][n];
        }
        if (fr == 15) {
#pragma unroll
            for (int ai = 0; ai < 2; ++ai)
#pragma unroll
                for (int bj = 0; bj < 2; ++bj)
#pragma unroll
                    for (int n = 0; n < 2; ++n) xl[xi(ai, wr, 1, wc, bj, n, fq)] = acc[ai][bj][3][n];
        }
        if (wr == 0 && fr < 2) {
#pragma unroll
            for (int bj = 0; bj < 2; ++bj)
#pragma unroll
                for (int n = 0; n < 2; ++n) { const f32x4 v = acc[0][bj][0][n]; u32x2v w; w.x = cvt_pk_bf16(v[0], v[1]); w.y = cvt_pk_bf16(v[2], v[3]);
                    *(u32x2v*)(UB + ((size_t)u.pm * 4 + fr) * 5632 + bj * 2816 + colg + 16 * n) = w; }
        }
        if (wr == 1 && fr >= 14) {
#pragma unroll
            for (int bj = 0; bj < 2; ++bj)
#pragma unroll
                for (int n = 0; n < 2; ++n) { const f32x4 v = acc[1][bj][3][n]; u32x2v w; w.x = cvt_pk_bf16(v[0], v[1]); w.y = cvt_pk_bf16(v[2], v[3]);
                    *(u32x2v*)(UB + ((size_t)u.pm * 4 + (fr - 12)) * 5632 + bj * 2816 + colg + 16 * n) = w; }
        }
        f32x4 w[3][2];
#pragma unroll
        for (int k = 0; k < 3; ++k)
#pragma unroll
            for (int bj = 0; bj < 2; ++bj) w[k][bj] = *(const f32x4*)(cw + k * 5632 + bj * 2816 + colg);
        asm volatile("s_waitcnt lgkmcnt(0)\n\ts_barrier" ::: "memory");
#pragma unroll
        for (int n = 0; n < 2; ++n) {
            if (n == 1) {
#pragma unroll
                for (int k = 0; k < 3; ++k)
#pragma unroll
                    for (int bj = 0; bj < 2; ++bj) w[k][bj] = *(const f32x4*)(cw + k * 5632 + bj * 2816 + colg + 16);
            }
#pragma unroll
            for (int ai = 0; ai < 2; ++ai) {
                const int pai = wr == 1 ? ai : (ai > 0 ? ai - 1 : 0), pwr = wr ^ 1;
                const int nai = wr == 0 ? ai : (ai < 1 ? ai + 1 : 1), nwr = wr ^ 1;
                f32x4 pvf[2], nxl[2];
#pragma unroll
                for (int bj = 0; bj < 2; ++bj) { pvf[bj] = xl[xi(pai, pwr, 1, wc, bj, n, fq)]; nxl[bj] = xl[xi(nai, nwr, 0, wc, bj, n, fq)]; }
#pragma unroll
                for (int m = 0; m < 4; ++m) {
                    const int row = ai * HALF + wr * 64 + m * 16 + fr;
                    f32x4 cv[2];
#pragma unroll
                    for (int bj = 0; bj < 2; ++bj) {
                        const f32x4 cur = acc[ai][bj][m][n];
                        const f32x4 pr = m > 0 ? acc[ai][bj][m > 0 ? m - 1 : 0][n] : pvf[bj];
                        const f32x4 nr = m < 3 ? acc[ai][bj][m < 3 ? m + 1 : 3][n] : nxl[bj];
                        const f32x4 mixp = fr == 15 ? pr : cur, mixn = fr == 0 ? nr : cur;
                        const f32x4 rp = {dpp_ror1(mixp[0]), dpp_ror1(mixp[1]), dpp_ror1(mixp[2]), dpp_ror1(mixp[3])};
                        const f32x4 rn = {dpp_ror15(mixn[0]), dpp_ror15(mixn[1]), dpp_ror15(mixn[2]), dpp_ror15(mixn[3])};
                        f32x4 c = w[1][bj] * cur;
                        c = rp * w[0][bj] + c;
                        c = rn * w[2][bj] + c;
                        cv[bj] = c;
                    }
                    const f32x4 t = cv[0] * (-1.4426950408889634f);
                    f32x4 d = {__builtin_amdgcn_exp2f(t[0]), __builtin_amdgcn_exp2f(t[1]), __builtin_amdgcn_exp2f(t[2]), __builtin_amdgcn_exp2f(t[3])};
                    d = d + 1.0f;
                    const f32x4 r = {__builtin_amdgcn_rcpf(d[0]), __builtin_amdgcn_rcpf(d[1]), __builtin_amdgcn_rcpf(d[2]), __builtin_amdgcn_rcpf(d[3])};
                    const f32x4 o = (cv[0] * cv[1]) * r;
                    { u32x2v pk; pk.x = cvt_pk_bf16(o[0], o[1]); pk.y = cvt_pk_bf16(o[2], o[3]);
                        *(u32x2v*)(ACT + (size_t)(u.pm * BM + row) * 2816 + colg + 16 * n) = pk; }
                    if (m & 1) __builtin_amdgcn_sched_barrier(0);
                }
            }
        }
    }
};

template <class Epi, class Sched, bool ALIGN_EPI = false, bool SP2 = false>
__device__ __forceinline__ void gemm_phase(PG8_LAS unsigned char* lds, const Gemm g, const Sched& S, const Epi& E) {
    int tid_ = threadIdx.x; asm volatile("" : "+v"(tid_));
    const int tid = tid_, wid = __builtin_amdgcn_readfirstlane(tid >> 6), lane = tid & 63, wr = wid >> 2, wc = wid & 3, fr = lane & 15, fq = lane >> 4;
    const int K = g.K, nt = K / BK;
    unsigned voffA[2], voffB[2];
#pragma unroll
    for (int i = 0; i < 2; ++i) { int R, C; stage_rc(tid * 16 + i * 8192, R, C); const int Rb = Epi::PERM ? ((R & ~31) + perm32(R & 31)) : R;
        voffA[i] = (unsigned)(R * K + C) * 2u; voffB[i] = (unsigned)(Rb * K + C) * 2u; }
    const size_t kstep = (size_t)(BK * 2);
    const size_t hstep = (size_t)HALF * K * 2;
    const size_t tstep = 2 * hstep;
    const unsigned ldsw = (unsigned)wid * 1024u;
    const int aoff = lds_byte(wr * 64 + fr, fq * 8), boff = lds_byte(wc * 32 + fr, fq * 8);
#define PG8_SA(b, h) (((b) * 2 + (h)) * HTB)
#define PG8_SB(b, h) ((4 + (b) * 2 + (h)) * HTB)
#define PG8_STAGE(bufoff, gbase, voff) do { _Pragma("unroll") for (int _i = 0; _i < 2; ++_i) \
        __builtin_amdgcn_global_load_lds((const unsigned*)((const char*)(gbase) + (voff)[_i]), (PG8_LAS unsigned*)(lds + (bufoff) + ldsw + _i * 8192), 16, 0, 0); } while (0)
#define PG8_LDA(dst, b, h) do { _Pragma("unroll") for (int m = 0; m < 4; ++m) _Pragma("unroll") for (int k = 0; k < 2; ++k) dst[m][k] = *(const PG8_LAS bf16x8*)(lds + PG8_SA(b, h) + aoff + m * 2048 + k * 1024); } while (0)
#define PG8_LDB(dst, b, h) do { _Pragma("unroll") for (int n = 0; n < 2; ++n) _Pragma("unroll") for (int k = 0; k < 2; ++k) dst[n][k] = *(const PG8_LAS bf16x8*)(lds + PG8_SB(b, h) + boff + n * 2048 + k * 1024); } while (0)
#define PG8_MMA(ai, bj, At, Bt) do { __builtin_amdgcn_s_setprio(1); _Pragma("unroll") for (int m = 0; m < 4; ++m) _Pragma("unroll") for (int n = 0; n < 2; ++n) _Pragma("unroll") for (int k = 0; k < 2; ++k) \
        acc[ai][bj][m][n] = __builtin_amdgcn_mfma_f32_16x16x32_bf16(Bt[n][k], At[m][k], acc[ai][bj][m][n], 0, 0, 0); __builtin_amdgcn_s_setprio(0); } while (0)
#define PG8_WAIT_V(n) asm volatile("s_waitcnt vmcnt(" #n ")" ::: "memory")
#define PG8_WAIT_L(n) asm volatile("s_waitcnt lgkmcnt(" #n ")" ::: "memory")
#define PG8_BAR __builtin_amdgcn_s_barrier()
#define PG8_SCHED __builtin_amdgcn_sched_barrier(0)
    Unit cur, nxt; int ui = 0;
    if (!S.next(0, cur)) return;
    f32x4 acc[2][2][4][2];
#pragma unroll
    for (int a = 0; a < 2; ++a)
#pragma unroll
        for (int b = 0; b < 2; ++b)
#pragma unroll
            for (int m = 0; m < 4; ++m)
#pragma unroll
                for (int n = 0; n < 2; ++n) acc[a][b][m][n] = (f32x4){0.f, 0.f, 0.f, 0.f};
    bf16x8 At[4][2], B0[2][2], B1[2][2];
    const char* cA = (const char*)g.A + (size_t)cur.pm * tstep + (size_t)cur.koff * 2; const char* cB = (const char*)g.Bt + (size_t)cur.pn * tstep + (size_t)cur.koff * 2;
    S.a_ready(cur);
    if constexpr (SP2) {
        PG8_STAGE(PG8_SB(0, 0), cB, voffB); PG8_STAGE(PG8_SB(0, 1), cB + hstep, voffB); PG8_STAGE(PG8_SA(0, 0), cA, voffA); PG8_STAGE(PG8_SA(0, 1), cA + hstep, voffA);
        if (wr == 1) PG8_BAR;
        PG8_WAIT_V(2); PG8_BAR;
        PG8_STAGE(PG8_SB(1, 0), cB + kstep, voffB); PG8_STAGE(PG8_SA(1, 0), cA + kstep, voffA); PG8_STAGE(PG8_SB(1, 1), cB + hstep + kstep, voffB);
        PG8_WAIT_V(6); PG8_BAR;
    } else {
        PG8_STAGE(PG8_SB(0, 0), cB, voffB); PG8_STAGE(PG8_SA(0, 0), cA, voffA); PG8_STAGE(PG8_SB(0, 1), cB + hstep, voffB); PG8_STAGE(PG8_SA(0, 1), cA + hstep, voffA);
        if (wr == 1) PG8_BAR;
        PG8_WAIT_V(4); PG8_BAR;
        PG8_STAGE(PG8_SB(1, 0), cB + kstep, voffB); PG8_STAGE(PG8_SA(1, 0), cA + kstep, voffA); PG8_STAGE(PG8_SB(1, 1), cB + hstep + kstep, voffB);
        PG8_WAIT_V(6); PG8_BAR;
    }
    for (;;) {
        const bool has_next = S.next(ui + 1, nxt);
        const char* nA = has_next ? (const char*)g.A + (size_t)nxt.pm * tstep + (size_t)nxt.koff * 2 : cA; const char* nB = has_next ? (const char*)g.Bt + (size_t)nxt.pn * tstep + (size_t)nxt.koff * 2 : cB;
        const int nt_u = cur.nt;
        for (int t = 0; t < nt_u; t += 2) {
            const bool last = (t == nt_u - 2);
            const char* a1 = cA + (size_t)(t + 1) * kstep;
            const char* a2 = last ? nA : cA + (size_t)(t + 2) * kstep; const char* b2 = last ? nB : cB + (size_t)(t + 2) * kstep;
            const char* a3 = a2 + kstep; const char* b3 = b2 + kstep;
            if (last && has_next) S.a_ready(nxt);
            if constexpr (SP2) {
            PG8_LDB(B0, 0, 0); PG8_LDB(B1, 0, 1); PG8_SCHED; PG8_LDA(At, 0, 0); PG8_STAGE(PG8_SA(1, 1), a1 + hstep, voffA);
            PG8_WAIT_V(8); PG8_WAIT_L(0); PG8_BAR; PG8_MMA(0, 0, At, B0); PG8_MMA(0, 1, At, B1); PG8_BAR; PG8_SCHED;
            PG8_LDA(At, 0, 1); PG8_STAGE(PG8_SB(0, 0), b2, voffB); PG8_STAGE(PG8_SB(0, 1), b2 + hstep, voffB); PG8_STAGE(PG8_SA(0, 0), a2, voffA);
            PG8_WAIT_V(8); PG8_WAIT_L(0); PG8_BAR; PG8_MMA(1, 0, At, B0); PG8_MMA(1, 1, At, B1); PG8_BAR; PG8_SCHED;
            PG8_LDB(B0, 1, 0); PG8_LDB(B1, 1, 1); PG8_SCHED; PG8_LDA(At, 1, 0); PG8_STAGE(PG8_SA(0, 1), a2 + hstep, voffA);
            PG8_WAIT_V(8); PG8_WAIT_L(0); PG8_BAR; PG8_MMA(0, 0, At, B0); PG8_MMA(0, 1, At, B1); PG8_BAR; PG8_SCHED;
            PG8_LDA(At, 1, 1); PG8_STAGE(PG8_SB(1, 0), b3, voffB); PG8_STAGE(PG8_SB(1, 1), b3 + hstep, voffB); PG8_STAGE(PG8_SA(1, 0), a3, voffA);
            PG8_WAIT_V(8); PG8_WAIT_L(0); PG8_BAR; PG8_MMA(1, 0, At, B0); PG8_MMA(1, 1, At, B1); PG8_BAR; PG8_SCHED;
            } else {
            PG8_LDB(B0, 0, 0); PG8_SCHED; PG8_LDA(At, 0, 0); PG8_STAGE(PG8_SA(1, 1), a1 + hstep, voffA);
            PG8_WAIT_L(8); PG8_BAR; PG8_WAIT_L(0); PG8_MMA(0, 0, At, B0); PG8_BAR; PG8_SCHED;
            PG8_LDB(B1, 0, 1); PG8_STAGE(PG8_SB(0, 0), b2, voffB);
            PG8_BAR; PG8_WAIT_L(0); PG8_MMA(0, 1, At, B1); PG8_BAR;
            PG8_LDA(At, 0, 1); PG8_STAGE(PG8_SA(0, 0), a2, voffA);
            PG8_BAR; PG8_WAIT_L(0); PG8_MMA(1, 0, At, B0); PG8_BAR; PG8_SCHED;
            PG8_STAGE(PG8_SB(0, 1), b2 + hstep, voffB);
            PG8_WAIT_V(6); PG8_BAR; PG8_MMA(1, 1, At, B1); PG8_BAR;
            PG8_LDB(B0, 1, 0); PG8_SCHED; PG8_LDA(At, 1, 0); PG8_STAGE(PG8_SA(0, 1), a2 + hstep, voffA);
            PG8_WAIT_L(8); PG8_BAR; PG8_WAIT_L(0); PG8_MMA(0, 0, At, B0); PG8_BAR; PG8_SCHED;
            PG8_LDB(B1, 1, 1); PG8_STAGE(PG8_SB(1, 0), b3, voffB);
            PG8_BAR; PG8_WAIT_L(0); PG8_MMA(0, 1, At, B1); PG8_BAR;
            PG8_LDA(At, 1, 1); PG8_STAGE(PG8_SA(1, 0), a3, voffA);
            PG8_BAR; PG8_WAIT_L(0); PG8_MMA(1, 0, At, B0); PG8_BAR; PG8_SCHED;
            PG8_STAGE(PG8_SB(1, 1), b3 + hstep, voffB);
            PG8_WAIT_V(6); PG8_BAR; PG8_MMA(1, 1, At, B1); PG8_BAR;
            }
        }
        if constexpr (ALIGN_EPI) { if (wr == 0) PG8_BAR; }
        if constexpr (!Epi::AFTER_DRAIN) { E(acc, cur, wr, wc, fr, fq); S.done(cur); }
        if (!has_next) break;
#pragma unroll
        for (int a = 0; a < 2; ++a)
#pragma unroll
            for (int b = 0; b < 2; ++b)
#pragma unroll
                for (int m = 0; m < 4; ++m)
#pragma unroll
                    for (int n = 0; n < 2; ++n) acc[a][b][m][n] = (f32x4){0.f, 0.f, 0.f, 0.f};
        cur = nxt; cA = nA; cB = nB; ++ui;
        if constexpr (ALIGN_EPI) { if (wr == 1) PG8_BAR; }
    }
    PG8_WAIT_V(0);
    if constexpr (!ALIGN_EPI) { if (wr == 0) PG8_BAR; }
    PG8_BAR;
    if constexpr (Epi::AFTER_DRAIN) { E.fused(acc, cur, wr, wc, fr, fq, lds, wid, lane); S.done(cur); }
#undef PG8_SA
#undef PG8_SB
#undef PG8_STAGE
#undef PG8_LDA
#undef PG8_LDB
#undef PG8_MMA
#undef PG8_WAIT_V
#undef PG8_WAIT_L
#undef PG8_BAR
#undef PG8_SCHED
}
}

constexpr int DM = 1024, T_P = 32768, T_ALL = 98304, S_P = 2048, S_S = 8192;
constexpr int ZC = 2304;
constexpr int DFF = 2816, UC = 2 * DFF;
constexpr float EPS = 1e-6f;
constexpr int NWAVES = 8;
constexpr int FFN_CHUNK = 32768, N_FFN_CHUNKS = 3;

#define LAS __attribute__((address_space(3)))
typedef unsigned short bf16_t;
typedef short bf16x8 __attribute__((ext_vector_type(8)));
typedef short s16x4 __attribute__((ext_vector_type(4)));
typedef float f32x4 __attribute__((ext_vector_type(4)));
typedef float f32x16 __attribute__((ext_vector_type(16)));
typedef unsigned u32x4 __attribute__((ext_vector_type(4)));
typedef unsigned u32x2 __attribute__((ext_vector_type(2)));

constexpr size_t MiB = 1u << 20;
constexpr size_t WS_MOD = 1 * MiB, WS_COS = 2 * MiB, WS_SIN = 3 * MiB;
constexpr size_t WS_WIN = 4 * MiB, WS_WUQ = 9 * MiB, WS_WUKV = 10 * MiB, WS_WO = 11 * MiB, WS_WUP = 13 * MiB, WS_WDN = 24 * MiB;
constexpr size_t WS_H = 32 * MiB;
constexpr size_t WS_Z = 224 * MiB;
constexpr size_t WS_QB = 224 * MiB, WS_KVB = 368 * MiB;
constexpr size_t WS_CQN = 656 * MiB, WS_CKVN = 728 * MiB, WS_KR = 776 * MiB;
constexpr size_t WS_YC = 788 * MiB;
constexpr size_t WS_ACT = 224 * MiB, WS_UB = 760 * MiB;
constexpr size_t WS_U_UNUSED = 0;
constexpr size_t WS_END = 980 * MiB;

constexpr int LDS_BYTES = 163840;

__device__ __forceinline__ float bf2f(unsigned short u) { return __uint_as_float((unsigned)u << 16); }
__device__ __forceinline__ float bflo(unsigned w) { return __uint_as_float(w << 16); }
__device__ __forceinline__ float bfhi(unsigned w) { return __uint_as_float(w & 0xffff0000u); }
__device__ __forceinline__ unsigned cvtpk(float lo, float hi) { unsigned r; asm volatile("v_cvt_pk_bf16_f32 %0, %1, %2" : "=v"(r) : "v"(lo), "v"(hi)); return r; }
__device__ __forceinline__ float wave_sum(float v) {
#pragma unroll
    for (int o = 1; o < 64; o <<= 1) v += __shfl_xor(v, o);
    return v;
}
__device__ __forceinline__ void unpack8(const u32x4 w, float* f) {
    f[0] = bflo(w.x); f[1] = bfhi(w.x); f[2] = bflo(w.y); f[3] = bfhi(w.y); f[4] = bflo(w.z); f[5] = bfhi(w.z); f[6] = bflo(w.w); f[7] = bfhi(w.w);
}
__device__ __forceinline__ u32x4 pack8(const float* f) {
    u32x4 w; w.x = cvtpk(f[0], f[1]); w.y = cvtpk(f[2], f[3]); w.z = cvtpk(f[4], f[5]); w.w = cvtpk(f[6], f[7]); return w;
}

namespace att {
constexpr float SCALE = 0.07216878364870322f;
constexpr float THR = 8.f;
constexpr float QC = SCALE * 1.4426950408889634f;
constexpr int SHM_V = 16384, SHM_K = 16384, SHM_KR = 8192;
constexpr int OFF_K = 0, OFF_KR = 3 * SHM_K, OFF_V = OFF_KR + 3 * SHM_KR, OFF_WS = OFF_V + 3 * SHM_V, OFF_QR = OFF_WS + 8 * 256, ATT_LDS = OFF_QR + 8 * 4096;
__device__ __forceinline__ void glds16(const void* gsrc, unsigned lds_dst) { unsigned keep;
    asm volatile("s_mov_b32 %0, m0\n\ts_mov_b32 m0, %2\n\ts_nop 0\n\tglobal_load_lds_dwordx4 %1, off\n\ts_mov_b32 m0, %0" : "=&s"(keep) : "v"(gsrc), "s"(lds_dst) : "memory"); }
#define KSWZ(row, colB) ((row) * 256 + ((colB) ^ (((row) & 15) << 4)))
#define KRSWZ(row, colB) ((row) * 128 + ((colB) ^ ((((row) >> 1) & 7) << 4)))
#define SBAR() __builtin_amdgcn_sched_barrier(0)
__device__ __forceinline__ int crow(int r, int hi) { return (r & 3) + 8 * (r >> 2) + 4 * hi; }

__device__ __forceinline__ void partialSM(f32x16& p0, f32x16& p1, float& m_ref, f32x16& negm, float& alpha, bool first) {
    constexpr float THR2 = THR * 1.4426950408889634f;
    float ma = p0[0], mb = p0[8], mc = p1[0], md = p1[8];
#pragma unroll
    for (int r = 1; r < 8; ++r) { ma = fmaxf(ma, p0[r]); mb = fmaxf(mb, p0[8 + r]); mc = fmaxf(mc, p1[r]); md = fmaxf(md, p1[8 + r]); }
    float pmax = fmaxf(fmaxf(ma, mb), fmaxf(mc, md));
    { auto rr = __builtin_amdgcn_permlane32_swap(__float_as_uint(pmax), __float_as_uint(pmax), false, false);
      pmax = fmaxf(__uint_as_float(rr[0]), __uint_as_float(rr[1])); }
    if (__builtin_expect(!first && __all(pmax <= THR2), 1)) { alpha = 1.f; }
    else { const float d = first ? pmax : fmaxf(pmax, 0.f); m_ref += d; alpha = first ? 1.f : __builtin_amdgcn_exp2f(-d);
#pragma unroll
        for (int r = 0; r < 16; ++r) { p0[r] -= d; p1[r] -= d; }
#pragma unroll
        for (int r = 0; r < 16; ++r) negm[r] = -m_ref; }
#pragma unroll
    for (int r = 0; r < 16; ++r) p0[r] = __builtin_amdgcn_exp2f(p0[r]);
}
__device__ __forceinline__ void finishSM(f32x16& p0, f32x16& p1, float alpha, float& l_reg, bf16x8& pa0, bf16x8& pa1, bf16x8& pa2, bf16x8& pa3) {
#pragma unroll
    for (int r = 0; r < 16; ++r) p1[r] = __builtin_amdgcn_exp2f(p1[r]);
    float sa = p0[0], sb = p0[8], sc = p1[0], sd = p1[8];
#pragma unroll
    for (int r = 1; r < 8; ++r) { sa += p0[r]; sb += p0[8 + r]; sc += p1[r]; sd += p1[8 + r]; }
    float ps = (sa + sb) + (sc + sd);
    { auto rr = __builtin_amdgcn_permlane32_swap(__float_as_uint(ps), __float_as_uint(ps), false, false);
      ps = __uint_as_float(rr[0]) + __uint_as_float(rr[1]); }
    l_reg = l_reg * alpha + ps;
#define PK4(P, BASE, OUT) do { unsigned a0 = cvtpk(P[BASE + 0], P[BASE + 1]), a1 = cvtpk(P[BASE + 2], P[BASE + 3]);   \
    unsigned b0 = cvtpk(P[BASE + 4], P[BASE + 5]), b1 = cvtpk(P[BASE + 6], P[BASE + 7]);                              \
    auto r0 = __builtin_amdgcn_permlane32_swap(a0, b0, false, false); auto r1 = __builtin_amdgcn_permlane32_swap(a1, b1, false, false); \
    u32x4 w = {r0[0], r1[0], r0[1], r1[1]}; OUT = *reinterpret_cast<bf16x8*>(&w); } while (0)
    PK4(p0, 0, pa0); PK4(p0, 8, pa1); PK4(p1, 0, pa2); PK4(p1, 8, pa3);
#undef PK4
}
__device__ __forceinline__ void qkt(f32x16& p0, f32x16& p1, const char* Ks, const char* Krs, const bf16x8* qr, const char* qro, int r32, int hi, const f32x16& negm) {
    p0 = negm; p1 = negm;
#pragma unroll
    for (int d0 = 0; d0 < 8; ++d0) { const int cb = (d0 * 16 + hi * 8) * 2;
        const bf16x8 b0 = *reinterpret_cast<const bf16x8*>(Ks + KSWZ(r32, cb));
        const bf16x8 b1 = *reinterpret_cast<const bf16x8*>(Ks + KSWZ(32 + r32, cb));
        p0 = __builtin_amdgcn_mfma_f32_32x32x16_bf16(b0, qr[d0], p0, 0, 0, 0);
        p1 = __builtin_amdgcn_mfma_f32_32x32x16_bf16(b1, qr[d0], p1, 0, 0, 0); }
#pragma unroll
    for (int d0 = 0; d0 < 4; ++d0) { const int cb = (d0 * 16 + hi * 8) * 2;
        const bf16x8 b0 = *reinterpret_cast<const bf16x8*>(Krs + KRSWZ(r32, cb));
        const bf16x8 b1 = *reinterpret_cast<const bf16x8*>(Krs + KRSWZ(32 + r32, cb));
        const bf16x8 qf = qr[8 + d0];
        p0 = __builtin_amdgcn_mfma_f32_32x32x16_bf16(b0, qf, p0, 0, 0, 0);
        p1 = __builtin_amdgcn_mfma_f32_32x32x16_bf16(b1, qf, p1, 0, 0, 0); }
}
__device__ __forceinline__ int v_st(int k, int c) { const int kk = (k & ~0xC) | ((k & 4) << 1) | ((k & 8) >> 1); return ((kk >> 3) * 4 + (c >> 5)) * 512 + ((kk & 7) * 32 + (c & 31)) * 2; }
__device__ __forceinline__ int v_rd_base(int lane) { return ((lane & 3) << 3) | (((lane >> 2) & 3) << 6) | (((lane >> 4) & 1) << 5) | (((lane >> 5) & 1) << 8); }
constexpr int v_rd_off(int d0, int ks, int half) { return d0 * 512 + ks * 4096 + half * 2048; }
template <int OFF> __device__ __forceinline__ s16x4 tr_read(int vb) {
    s16x4 r; asm volatile("ds_read_b64_tr_b16 %0, %1 offset:%2" : "=&v"(r) : "v"(vb), "i"(OFF) : "memory"); return r;
}
template <int D0> __device__ __forceinline__ void pv_one(f32x16& od, int vb, bf16x8 pa0, bf16x8 pa1, bf16x8 pa2, bf16x8 pa3) {
    const s16x4 l0 = tr_read<v_rd_off(D0, 0, 0)>(vb), h0 = tr_read<v_rd_off(D0, 0, 1)>(vb), l1 = tr_read<v_rd_off(D0, 1, 0)>(vb), h1 = tr_read<v_rd_off(D0, 1, 1)>(vb);
    const s16x4 l2 = tr_read<v_rd_off(D0, 2, 0)>(vb), h2 = tr_read<v_rd_off(D0, 2, 1)>(vb), l3 = tr_read<v_rd_off(D0, 3, 0)>(vb), h3 = tr_read<v_rd_off(D0, 3, 1)>(vb);
    asm volatile("s_waitcnt lgkmcnt(0)" ::: "memory"); SBAR();
#define PK(L, H) (bf16x8){L[0], L[1], L[2], L[3], H[0], H[1], H[2], H[3]}
    od = __builtin_amdgcn_mfma_f32_32x32x16_bf16(pa0, PK(l0, h0), od, 0, 0, 0);
    od = __builtin_amdgcn_mfma_f32_32x32x16_bf16(pa1, PK(l1, h1), od, 0, 0, 0);
    od = __builtin_amdgcn_mfma_f32_32x32x16_bf16(pa2, PK(l2, h2), od, 0, 0, 0);
    od = __builtin_amdgcn_mfma_f32_32x32x16_bf16(pa3, PK(l3, h3), od, 0, 0, 0);
#undef PK
}
__device__ __forceinline__ void pv_d0(f32x16* o, int vb, bf16x8 pa0, bf16x8 pa1, bf16x8 pa2, bf16x8 pa3) {
    pv_one<0>(o[0], vb, pa0, pa1, pa2, pa3); pv_one<1>(o[1], vb, pa0, pa1, pa2, pa3); pv_one<2>(o[2], vb, pa0, pa1, pa2, pa3); pv_one<3>(o[3], vb, pa0, pa1, pa2, pa3);
}

__device__ __forceinline__ void attn_unit(const bf16_t* __restrict__ Qb, const bf16_t* __restrict__ Kh, const bf16_t* __restrict__ Vh, const bf16_t* __restrict__ Krh,
                                          bf16_t* __restrict__ Ob, const float* __restrict__ cosq, const float* __restrict__ sinq, int seq, char* lds) {
    int tid_ = threadIdx.x; asm volatile("" : "+v"(tid_));
    const int tid = tid_, wid = tid >> 6, lane = tid & 63, r32 = lane & 31, hi = lane >> 5;
    char* V_lds = lds + OFF_V; char* K_lds = lds + OFF_K; char* Kr_lds = lds + OFF_KR;
    float* ws = (float*)(lds + OFF_WS) + wid * 64; float* li_l = ws; float* al_l = ws + 32;
    float m_reg = 0.f, l_reg = 0; f32x16 negm = {}; f32x16 o[4] = {}; bf16x8 qr[12];
    const char* qro = nullptr;
    const bf16_t* Qw = Qb + (long)(wid * 32 + r32) * 768 + hi * 8;
#pragma unroll
    for (int d0 = 0; d0 < 8; ++d0) { float qf_[8]; unpack8(*reinterpret_cast<const u32x4*>(Qw + d0 * 16), qf_);
#pragma unroll
        for (int j = 0; j < 8; ++j) qf_[j] *= QC;
        qr[d0] = __builtin_bit_cast(bf16x8, pack8(qf_)); }
    {
        const float* cp = cosq + (wid * 32 + r32) * 32 + hi * 8; const float* sp = sinq + (wid * 32 + r32) * 32 + hi * 8;
#pragma unroll
        for (int g = 0; g < 2; ++g) {
            float c[8], s[8], x1[8], x2[8], y1[8], y2[8];
            *(f32x4*)&c[0] = *(const f32x4*)(cp + g * 16); *(f32x4*)&c[4] = *(const f32x4*)(cp + g * 16 + 4);
            *(f32x4*)&s[0] = *(const f32x4*)(sp + g * 16); *(f32x4*)&s[4] = *(const f32x4*)(sp + g * 16 + 4);
            unpack8(*reinterpret_cast<const u32x4*>(Qw + (8 + g) * 16), x1); unpack8(*reinterpret_cast<const u32x4*>(Qw + (10 + g) * 16), x2);
#pragma unroll
            for (int j = 0; j < 8; ++j) { y1[j] = (x1[j] * c[j] - x2[j] * s[j]) * QC; y2[j] = (x2[j] * c[j] + x1[j] * s[j]) * QC; }
            qr[8 + g] = __builtin_bit_cast(bf16x8, pack8(y1)); qr[10 + g] = __builtin_bit_cast(bf16x8, pack8(y2));
        }
    }
    const bf16_t* ksrc[2]; const bf16_t* vsrc[2]; const bf16_t* krsrc;
#pragma unroll
    for (int i = 0; i < 2; ++i) { const int p = (wid * 2 + i) * 64 + lane;
        { const int row = p >> 4, c = (p & 15) ^ (row & 15); ksrc[i] = Kh + (long)row * 1024 + c * 8; }
        { const int s = p >> 5, q = p & 31, kk = (s >> 2) * 8 + (q >> 2), k = (kk & ~0xC) | ((kk & 4) << 1) | ((kk & 8) >> 1), c = (s & 3) * 32 + (q & 3) * 8; vsrc[i] = Vh + (long)k * 1024 + c; } }
    { const int p = wid * 64 + lane, row = p >> 3, c = (p & 7) ^ ((row >> 1) & 7); krsrc = Krh + (long)row * 64 + c * 8; }
    const unsigned lds0 = (unsigned)(uintptr_t)lds;
    const unsigned kdst = lds0 + OFF_K + wid * 2048, krdst = lds0 + OFF_KR + wid * 1024, vdst = lds0 + OFF_V + wid * 2048;
#define DMA_K(t, slot) do { glds16(ksrc[0] + (long)(t) * 65536, (unsigned)__builtin_amdgcn_readfirstlane(kdst + (slot) * SHM_K)); \
    glds16(ksrc[1] + (long)(t) * 65536, (unsigned)__builtin_amdgcn_readfirstlane(kdst + (slot) * SHM_K + 1024)); \
    glds16(krsrc + (long)(t) * 4096, (unsigned)__builtin_amdgcn_readfirstlane(krdst + (slot) * SHM_KR)); } while (0)
#define DMA_V(t, slot) do { glds16(vsrc[0] + (long)(t) * 65536, (unsigned)__builtin_amdgcn_readfirstlane(vdst + (slot) * SHM_V)); \
    glds16(vsrc[1] + (long)(t) * 65536, (unsigned)__builtin_amdgcn_readfirstlane(vdst + (slot) * SHM_V + 1024)); } while (0)
#define WAIT_BAR(N) asm volatile("s_waitcnt vmcnt(" #N ") lgkmcnt(0)\n\ts_barrier" ::: "memory")
    const int vb0 = (int)(uintptr_t)V_lds + v_rd_base(lane);
    const int NT = seq / 64;
#define RESC(a) do { if (__any((a) < 1.f)) { if (hi == 0) al_l[r32] = (a); asm volatile("s_waitcnt lgkmcnt(0)" ::: "memory"); \
    _Pragma("unroll") for (int d = 0; d < 4; ++d) _Pragma("unroll") for (int r = 0; r < 16; ++r) o[d][r] *= al_l[crow(r, hi)]; } } while (0)
    f32x16 p0, p1; float al = 1.f, mn_; bf16x8 pa0, pa1, pa2, pa3;
    asm volatile("s_waitcnt vmcnt(0) lgkmcnt(0)" ::: "memory");
    DMA_K(0, 0); DMA_V(0, 0); DMA_K(1, 1);
    WAIT_BAR(0);
    int s0 = 2, s1 = 0, s2 = 1;
    for (int j = 0; j < NT; ++j) {
        if (j + 1 < NT) DMA_V(j + 1, s2);
        if (j + 2 < NT) DMA_K(j + 2, s0);
        qkt(p0, p1, K_lds + s1 * SHM_K, Kr_lds + s1 * SHM_KR, qr, qro, r32, hi, negm);
        partialSM(p0, p1, m_reg, negm, al, j == 0); finishSM(p0, p1, al, l_reg, pa0, pa1, pa2, pa3);
        RESC(al);
        pv_d0(o, vb0 + s1 * SHM_V, pa0, pa1, pa2, pa3);
        if (j + 2 < NT) { WAIT_BAR(3); } else { WAIT_BAR(0); }
        { const int t_ = s0; s0 = s1; s1 = s2; s2 = t_; }
    }
#undef RESC
#undef DMA_K
#undef DMA_V
#undef WAIT_BAR
    if (hi == 0) li_l[r32] = l_reg; asm volatile("s_waitcnt lgkmcnt(0)" ::: "memory");
    float rli[16];
#pragma unroll
    for (int r = 0; r < 16; ++r) rli[r] = __builtin_amdgcn_rcpf(li_l[crow(r, hi)]);
    bf16_t* Ow = Ob + (long)(wid * 32) * 1024;
#pragma unroll
    for (int r = 0; r < 16; ++r) { const int orow = crow(r, hi);
#pragma unroll
        for (int d0 = 0; d0 < 4; ++d0) Ow[(long)orow * 1024 + d0 * 32 + r32] = (bf16_t)(cvtpk(o[d0][r] * rli[r], 0.f) & 0xffffu); }
    asm volatile("s_waitcnt lgkmcnt(0)" ::: "memory");
}
}

#define GAS __attribute__((address_space(1)))
#define XB_TMO      128
#define XB_XCNT(j)  (256  + 64 * (j))
#define XB_XSUB(j)  (1280 + 64 * (j))
#define XB_XGEN(j)  (2304 + 64 * (j))
#define XB_TOP      3328
#define XB_TOPGEN   3392
#define XCD_BAR_WORDS 3456
#define XB_SPIN_CAP (1u << 18)

__device__ __forceinline__ unsigned xb_ld(unsigned* p)              { return __hip_atomic_load(p, __ATOMIC_RELAXED, __HIP_MEMORY_SCOPE_AGENT); }
__device__ __forceinline__ unsigned xb_add(unsigned* p, unsigned v) { return __hip_atomic_fetch_add(p, v, __ATOMIC_RELAXED, __HIP_MEMORY_SCOPE_AGENT); }
__device__ __forceinline__ unsigned xb_xcc_id() { return (unsigned)__builtin_amdgcn_s_getreg((3 << 11) | 20) & 0xFu; }
#define XB_SPIN(cond, bar) do { unsigned _sp = 0; while (cond) { __builtin_amdgcn_s_sleep(1); \
    if ((++_sp & 255u) == 0u) { if (xb_ld(&(bar)[XB_TMO])) break; if (_sp > XB_SPIN_CAP) { atomicAdd(&(bar)[XB_TMO], 1u); break; } } } } while (0)

struct XcdBarrier {
    unsigned* bar; unsigned x;
    volatile LAS unsigned* st;
};

__device__ __forceinline__ XcdBarrier xcd_barrier_post(unsigned* bar, volatile LAS unsigned* st) {
    XcdBarrier b; b.bar = bar; b.x = xb_xcc_id(); b.st = st;
    if (threadIdx.x == 0) (void)xb_add(&bar[XB_XCNT(b.x)], 1u);
    return b;
}
__device__ __forceinline__ void xcd_barrier_complete(unsigned* bar, unsigned x, unsigned& nloc, unsigned& nx) {
    const unsigned G = gridDim.x * gridDim.y * gridDim.z;
    unsigned sum, cnt, mine, sp = 0u;
    for (;;) {
        sum = 0u; cnt = 0u; mine = 0u;
#pragma unroll
        for (unsigned j = 0; j < 16; ++j) { const unsigned c = xb_ld(&bar[XB_XCNT(j)]); sum += c; cnt += (c > 0u) ? 1u : 0u; mine = (j == x) ? c : mine; }
        if (sum == G) break;
        __builtin_amdgcn_s_sleep(1);
        if ((++sp & 255u) == 0u) { if (xb_ld(&bar[XB_TMO])) break; if (sp > XB_SPIN_CAP) { atomicAdd(&bar[XB_TMO], 1u); break; } }
    }
    nloc = mine > 0u ? mine : 1u; nx = cnt > 0u ? cnt : 1u;
}

__device__ __forceinline__ void xcd_barrier(const XcdBarrier& b) {
    asm volatile("s_waitcnt vmcnt(0)" ::: "memory");
    __syncthreads();
    if (threadIdx.x == 0) {
        unsigned* bar = b.bar;
        __builtin_amdgcn_s_waitcnt(0);
        unsigned nloc = b.st[0], nx = b.st[1];
        if (nloc == 0u) { xcd_barrier_complete(bar, b.x, nloc, nx); b.st[0] = nloc; b.st[1] = nx; }
        const unsigned old = xb_add(&bar[XB_XSUB(b.x)], 1u);
        const unsigned gen = old / nloc;
        if (old + 1u == (gen + 1u) * nloc) {
            __builtin_amdgcn_fence(__ATOMIC_RELEASE, "agent");
            asm volatile("s_waitcnt vmcnt(0)" ::: "memory");
            const unsigned og = xb_add(&bar[XB_TOP], 1u);
            const unsigned tg = og / nx;
            if (og + 1u == (tg + 1u) * nx) xb_add(&bar[XB_TOPGEN], 1u);
            else XB_SPIN(xb_ld(&bar[XB_TOPGEN]) == tg, bar);
            __builtin_amdgcn_fence(__ATOMIC_ACQUIRE, "agent");
            xb_add(&bar[XB_XGEN(b.x)], 1u);
            asm volatile("s_waitcnt vmcnt(0)" ::: "memory");
        } else {
            XB_SPIN(xb_ld(&bar[XB_XGEN(b.x)]) == gen, bar);
            __builtin_amdgcn_fence(__ATOMIC_ACQUIRE, "agent");
            asm volatile("s_waitcnt vmcnt(0)" ::: "memory");
        }
    }
    __syncthreads();
}

struct Args { const float* in[21]; float* out; unsigned char* ws; };

struct Ctx {
    int tid, lane, wave, vcu, G, gw, NGW;
    LAS unsigned char* lds;
};

__device__ __forceinline__ void tok_info(int t, int& bi, int& pos, int& S) {
    if (t < T_P) { bi = t >> 11; pos = t & (S_P - 1); S = S_P; } else { const int u = t - T_P; bi = 16 + (u >> 13); pos = u & (S_S - 1); S = S_S; }
}

template <bool GATE_REMAP = false>
__device__ __forceinline__ void p0_transpose_item(const float* W, int K, int N, bf16_t* WT, LAS float* scr, int item, int lane) {
    const int nblk = N / 32, kb = item / nblk, nb = item % nblk, k0 = 64 * kb, n0 = 32 * nb;
    int nd0 = n0; if (GATE_REMAP) { const int half = n0 / DFF, cc = n0 % DFF; nd0 = (cc / 128) * 256 + half * 128 + (cc % 128); }
#pragma unroll 8
    for (int i = 0; i < 32; ++i) { const int kk = 2 * i + (lane >> 5); scr[kk * 33 + (lane & 31)] = W[(size_t)(k0 + kk) * N + n0 + (lane & 31)]; }
    asm volatile("s_waitcnt lgkmcnt(0)" ::: "memory");
    const int c = lane & 7;
#pragma unroll
    for (int j = 0; j < 4; ++j) { const int n = (lane >> 3) + 8 * j; const LAS float* s = scr + (8 * c) * 33 + n;
        u32x4 o; o.x = cvtpk(s[0 * 33], s[1 * 33]); o.y = cvtpk(s[2 * 33], s[3 * 33]); o.z = cvtpk(s[4 * 33], s[5 * 33]); o.w = cvtpk(s[6 * 33], s[7 * 33]);
        *(u32x4*)(WT + (size_t)(nd0 + n) * K + k0 + 8 * c) = o; }
    asm volatile("s_waitcnt lgkmcnt(0)" ::: "memory");
}

__device__ __forceinline__ void mod_gemv(const Ctx& X, const float* c_p, const float* c_s, const float* w_ada, const float* b_ada, float* mod, int j0) {
    LAS float* cact = (LAS float*)X.lds;
    for (int i = X.tid; i < 24 * 1024; i += 512) { const float c = i < 16 * 1024 ? c_p[i] : c_s[i - 16 * 1024]; cact[i] = c / (1.f + __expf(-c)); }
    __syncthreads();
    float acc[24];
#pragma unroll
    for (int b = 0; b < 24; ++b) acc[b] = 0.f;
    const int kbeg = X.wave * 128;
#pragma unroll 4
    for (int kk = 0; kk < 128; ++kk) { const int k = kbeg + kk; const float wv = w_ada[(size_t)k * 6144 + j0 + X.lane];
#pragma unroll
        for (int b = 0; b < 24; ++b) acc[b] = fmaf(cact[b * 1024 + k], wv, acc[b]); }
    __syncthreads();
    LAS float* red = (LAS float*)X.lds;
#pragma unroll
    for (int b = 0; b < 24; ++b) red[(X.wave * 24 + b) * 64 + X.lane] = acc[b];
    __syncthreads();
    for (int i = X.tid; i < 24 * 64; i += 512) { const int b = i >> 6, l = i & 63; float s = b_ada[j0 + l];
#pragma unroll
        for (int w = 0; w < 8; ++w) s += red[(w * 24 + b) * 64 + l];
        mod[b * 6144 + j0 + l] = s; }
    __syncthreads();
}

__device__ __forceinline__ void modnorm_phase(const Ctx& X, const float* src_p, const float* src_s, const float* g, const float* mod, int sh_off, int sc_off, bf16_t* H) {
    for (int ch = X.gw; ch < T_ALL / 16; ch += X.NGW) {
        const int t0 = ch * 16; int bi, pos, S; tok_info(t0, bi, pos, S);
        const float* src = t0 < T_P ? src_p : src_s;
        const float* mp = mod + bi * 6144;
        f32x4 gs[4], sh[4];
#pragma unroll
        for (int j = 0; j < 4; ++j) { const int c = X.lane * 4 + 256 * j; const f32x4 gg = *(const f32x4*)(g + c), sc = *(const f32x4*)(mp + sc_off + c);
            gs[j] = gg * (sc + 1.0f); sh[j] = *(const f32x4*)(mp + sh_off + c); }
#pragma unroll 2
        for (int r = 0; r < 16; ++r) {
            const float* xr = src + (size_t)(t0 + r) * DM + X.lane * 4;
            f32x4 v[4]; float ss = 0.f;
#pragma unroll
            for (int j = 0; j < 4; ++j) { v[j] = *(const f32x4*)(xr + 256 * j); ss += (v[j].x * v[j].x + v[j].y * v[j].y) + (v[j].z * v[j].z + v[j].w * v[j].w); }
            const float rstd = rsqrtf(wave_sum(ss) * (1.f / DM) + EPS);
            bf16_t* orow = H + (size_t)(t0 + r) * DM + X.lane * 4;
#pragma unroll
            for (int j = 0; j < 4; ++j) { const f32x4 o = v[j] * rstd * gs[j] + sh[j]; u32x2 w; w.x = cvtpk(o.x, o.y); w.y = cvtpk(o.z, o.w); *(u32x2*)(orow + 256 * j) = w; }
        }
    }
}

__device__ __forceinline__ void p3_phase(const Ctx& X, const bf16_t* Z, const float* conv_w, const float* ga, const float* gq, const float* gkv,
                                         const float* cosT, const float* sinT, bf16_t* YC, bf16_t* CQN, bf16_t* CKVN, bf16_t* KR) {
    const int lane = X.lane, c8 = lane * 8;
    float w0[8], w1[8], w2[8], gav[8], gqv[8], gkvv[8];
#pragma unroll
    for (int j = 0; j < 8; ++j) { w0[j] = conv_w[c8 + j]; w1[j] = conv_w[512 + c8 + j]; w2[j] = conv_w[1024 + c8 + j]; gav[j] = ga[c8 + j];
        gqv[j] = lane < 48 ? gq[c8 + j] : 0.f; gkvv[j] = lane < 32 ? gkv[c8 + j] : 0.f; }
    for (int ch = X.gw; ch < T_ALL / 16; ch += X.NGW) {
        const int t0 = ch * 16; int bi, pos0, S; tok_info(t0, bi, pos0, S);
        float prev[8], cur[8], nxt[8];
#define LOADP(dst, t) do { const u32x4 ha_ = *(const u32x4*)(Z + (size_t)(t) * ZC + c8), ca_ = *(const u32x4*)(Z + (size_t)(t) * ZC + 1024 + c8); \
        float hf_[8], cf_[8]; unpack8(ha_, hf_); unpack8(ca_, cf_); _Pragma("unroll") for (int j = 0; j < 8; ++j) dst[j] = hf_[j] * cf_[j]; } while (0)
        if (pos0 == 0) {
#pragma unroll
            for (int j = 0; j < 8; ++j) prev[j] = 0.f;
        } else LOADP(prev, t0 - 1);
        LOADP(cur, t0);
        for (int i = 0; i < 16; ++i) {
            const int t = t0 + i, pos = pos0 + i;
            if (pos == S - 1) {
#pragma unroll
                for (int j = 0; j < 8; ++j) nxt[j] = 0.f;
            } else LOADP(nxt, t + 1);
            const bf16_t* zr = Z + (size_t)t * ZC;
            float bf[8]; unpack8(*(const u32x4*)(zr + 512 + c8), bf);
            float y[8]; float ss_a = 0.f;
#pragma unroll
            for (int j = 0; j < 8; ++j) { y[j] = bf[j] * (w0[j] * prev[j] + w1[j] * cur[j] + w2[j] * nxt[j]); ss_a += y[j] * y[j]; }
            float q[8]; float ss_q = 0.f;
            if (lane < 48) { unpack8(*(const u32x4*)(zr + 1536 + c8), q);
#pragma unroll
                for (int j = 0; j < 8; ++j) ss_q += q[j] * q[j]; }
            float kv[8]; float ss_k = 0.f;
            if (lane < 32) { unpack8(*(const u32x4*)(zr + 1920 + c8), kv);
#pragma unroll
                for (int j = 0; j < 8; ++j) ss_k += kv[j] * kv[j]; }
#pragma unroll
            for (int o = 1; o < 64; o <<= 1) { ss_a += __shfl_xor(ss_a, o); ss_q += __shfl_xor(ss_q, o); ss_k += __shfl_xor(ss_k, o); }
            const float ra = rsqrtf(ss_a * (1.f / 512.f) + EPS), rq = rsqrtf(ss_q * (1.f / 384.f) + EPS), rk = rsqrtf(ss_k * (1.f / 256.f) + EPS);
#pragma unroll
            for (int j = 0; j < 8; ++j) y[j] = y[j] * ra * gav[j];
            *(u32x4*)(YC + (size_t)t * DM + c8) = pack8(y);
            if (lane < 48) {
#pragma unroll
                for (int j = 0; j < 8; ++j) q[j] = q[j] * rq * gqv[j];
                *(u32x4*)(CQN + (size_t)t * 384 + c8) = pack8(q); }
            if (lane < 32) {
#pragma unroll
                for (int j = 0; j < 8; ++j) kv[j] = kv[j] * rk * gkvv[j];
                *(u32x4*)(CKVN + (size_t)t * 256 + c8) = pack8(kv); }
            if (lane < 8) {
                const u32x2 a = *(const u32x2*)(zr + 2176 + lane * 4), b = *(const u32x2*)(zr + 2176 + 32 + lane * 4);
                const f32x4 c = *(const f32x4*)(cosT + pos * 32 + lane * 4), s = *(const f32x4*)(sinT + pos * 32 + lane * 4);
                const f32x4 x1 = {bflo(a.x), bfhi(a.x), bflo(a.y), bfhi(a.y)}, x2 = {bflo(b.x), bfhi(b.x), bflo(b.y), bfhi(b.y)};
                const f32x4 y1 = x1 * c - x2 * s, y2 = x2 * c + x1 * s;
                u32x2 o1, o2; o1.x = cvtpk(y1.x, y1.y); o1.y = cvtpk(y1.z, y1.w); o2.x = cvtpk(y2.x, y2.y); o2.y = cvtpk(y2.z, y2.w);
                *(u32x2*)(KR + (size_t)t * 64 + lane * 4) = o1; *(u32x2*)(KR + (size_t)t * 64 + 32 + lane * 4) = o2;
            }
#pragma unroll
            for (int j = 0; j < 8; ++j) { prev[j] = cur[j]; cur[j] = nxt[j]; }
        }
#undef LOADP
    }
}

__device__ __forceinline__ void p5b_phase(const Ctx& X, bf16_t* YC, const float* gb) {
    const int c8 = X.lane * 8; float g[8];
#pragma unroll
    for (int j = 0; j < 8; ++j) g[j] = gb[c8 + j];
    for (int ch = X.gw; ch < T_ALL / 16; ch += X.NGW) {
#pragma unroll 4
        for (int i = 0; i < 16; ++i) { bf16_t* p = YC + (size_t)(ch * 16 + i) * DM + 512 + c8;
            float v[8]; unpack8(*(const u32x4*)p, v); float ss = 0.f;
#pragma unroll
            for (int j = 0; j < 8; ++j) ss += v[j] * v[j];
            const float r = rsqrtf(wave_sum(ss) * (1.f / 512.f) + EPS);
#pragma unroll
            for (int j = 0; j < 8; ++j) v[j] = v[j] * r * g[j];
            *(u32x4*)p = pack8(v); }
    }
}

__device__ __forceinline__ void p9_fixup_phase(const Ctx& X, const bf16_t* UB, const float* cw, bf16_t* ACT) {
    const int nitems = (T_ALL / 256) * 2 * 6;
    for (int it = X.gw; it < nitems; it += X.NGW) {
        const int cb = it % 6, tb = it / 6, pm = tb >> 1, bot = tb & 1; const int c0 = cb * 512 + X.lane * 8;
        if (c0 >= DFF) continue;
        const int t = pm * 256 + (bot ? 255 : 0); const int S = t < T_P ? S_P : S_S; const int pos = t & (S - 1);
        const u32x4 zero = {0u, 0u, 0u, 0u};
        const bf16_t* r0; const bf16_t* r1; const bf16_t* r2; bool z0 = false, z2 = false;
        if (!bot) { z0 = (pos == 0); r0 = UB + ((size_t)(pm > 0 ? pm - 1 : 0) * 4 + 3) * UC; r1 = UB + ((size_t)pm * 4 + 0) * UC; r2 = UB + ((size_t)pm * 4 + 1) * UC; }
        else { z2 = (pos == S - 1); r0 = UB + ((size_t)pm * 4 + 2) * UC; r1 = UB + ((size_t)pm * 4 + 3) * UC; r2 = UB + ((size_t)(pm < T_ALL / 256 - 1 ? pm + 1 : pm) * 4 + 0) * UC; }
        float o[8], g[8], a[8], b[8], c[8];
        { const u32x4 x0 = z0 ? zero : *(const u32x4*)(r0 + c0), x1 = *(const u32x4*)(r1 + c0), x2 = z2 ? zero : *(const u32x4*)(r2 + c0);
          unpack8(x0, a); unpack8(x1, b); unpack8(x2, c);
#pragma unroll
          for (int j = 0; j < 8; ++j) g[j] = cw[c0 + j] * a[j] + cw[UC + c0 + j] * b[j] + cw[2 * UC + c0 + j] * c[j]; }
        { const u32x4 x0 = z0 ? zero : *(const u32x4*)(r0 + DFF + c0), x1 = *(const u32x4*)(r1 + DFF + c0), x2 = z2 ? zero : *(const u32x4*)(r2 + DFF + c0);
          unpack8(x0, a); unpack8(x1, b); unpack8(x2, c);
#pragma unroll
          for (int j = 0; j < 8; ++j) { const float v = cw[DFF + c0 + j] * a[j] + cw[UC + DFF + c0 + j] * b[j] + cw[2 * UC + DFF + c0 + j] * c[j]; o[j] = g[j] / (1.f + __expf(-g[j])) * v; } }
        *(u32x4*)(ACT + (size_t)t * DFF + c0) = pack8(o);
    }
}

__device__ __forceinline__ void final_norm_phase(const Ctx& X, float* out, const float* g) {
    f32x4 gv[4];
#pragma unroll
    for (int j = 0; j < 4; ++j) gv[j] = *(const f32x4*)(g + X.lane * 4 + 256 * j);
    for (int ch = X.gw; ch < T_ALL / 16; ch += X.NGW) {
#pragma unroll 2
        for (int r = 0; r < 16; ++r) { float* xr = out + (size_t)(ch * 16 + r) * DM + X.lane * 4;
            f32x4 v[4]; float ss = 0.f;
#pragma unroll
            for (int j = 0; j < 4; ++j) { v[j] = *(const f32x4*)(xr + 256 * j); ss += (v[j].x * v[j].x + v[j].y * v[j].y) + (v[j].z * v[j].z + v[j].w * v[j].w); }
            const float rstd = rsqrtf(wave_sum(ss) * (1.f / DM) + EPS);
#pragma unroll
            for (int j = 0; j < 4; ++j) *(f32x4*)(xr + 256 * j) = v[j] * rstd * gv[j]; }
    }
}

__global__ void __launch_bounds__(512, 2) fwd_kernel(Args args) {
    extern __shared__ __attribute__((aligned(16))) unsigned char lds[];
    cg::grid_group grid = cg::this_grid();
    Ctx X; { int t_ = threadIdx.x; asm volatile("" : "+v"(t_)); X.tid = t_; } X.lane = X.tid & 63; X.wave = __builtin_amdgcn_readfirstlane(X.tid >> 6);
    X.G = gridDim.x; { const int bx = blockIdx.x; X.vcu = (X.G % 8 == 0) ? (bx % 8) * (X.G / 8) + bx / 8 : bx; }
    X.gw = X.vcu * NWAVES + X.wave; X.NGW = X.G * NWAVES; X.lds = (LAS unsigned char*)lds;
    unsigned char* ws = args.ws;
    volatile LAS unsigned* bar_st = (volatile LAS unsigned*)(X.lds + (LDS_BYTES - 64));
    if (threadIdx.x < 2) bar_st[threadIdx.x] = 0u;
    __syncthreads();
    XcdBarrier bar = xcd_barrier_post((unsigned*)ws, bar_st);
    const float* x_p = args.in[0]; const float* x_s = args.in[1];
    float* mod = (float*)(ws + WS_MOD); float* cosT = (float*)(ws + WS_COS); float* sinT = (float*)(ws + WS_SIN);
    bf16_t* Win_t = (bf16_t*)(ws + WS_WIN); bf16_t* Wuq_t = (bf16_t*)(ws + WS_WUQ); bf16_t* Wukv_t = (bf16_t*)(ws + WS_WUKV);
    bf16_t* Wo_t = (bf16_t*)(ws + WS_WO); bf16_t* Wup_t = (bf16_t*)(ws + WS_WUP); bf16_t* Wdn_t = (bf16_t*)(ws + WS_WDN);
    bf16_t* H = (bf16_t*)(ws + WS_H); bf16_t* Z = (bf16_t*)(ws + WS_Z); bf16_t* QB = (bf16_t*)(ws + WS_QB); bf16_t* KVB = (bf16_t*)(ws + WS_KVB);
    bf16_t* CQN = (bf16_t*)(ws + WS_CQN); bf16_t* CKVN = (bf16_t*)(ws + WS_CKVN); bf16_t* KR = (bf16_t*)(ws + WS_KR); bf16_t* YC = (bf16_t*)(ws + WS_YC);
    bf16_t* ACT = (bf16_t*)(ws + WS_ACT); bf16_t* UB = (bf16_t*)(ws + WS_UB);
    float* out = args.out;

    {
#ifndef NO_MODGEMV
        if (blockIdx.x < 96) mod_gemv(X, args.in[2], args.in[3], args.in[4], args.in[5], mod, blockIdx.x * 64);
#endif
        LAS float* scr = (LAS float*)(X.lds + X.wave * 16384);
        constexpr int I_IN = 16 * 70, I_UQ = 6 * 24, I_UKV = 4 * 32, I_O = 16 * 32, I_UP = 16 * 176, I_DN = 44 * 32;
        constexpr int NITEMS = I_IN + I_UQ + I_UKV + I_O + I_UP + I_DN;
        for (int it = X.gw; it < NITEMS; it += X.NGW) {
            int r = it;
            if (r < I_IN) { p0_transpose_item(args.in[7], 1024, 2240, Win_t, scr, r, X.lane); continue; } r -= I_IN;
            if (r < I_UQ) { p0_transpose_item(args.in[10], 384, 768, Wuq_t, scr, r, X.lane); continue; } r -= I_UQ;
            if (r < I_UKV) { p0_transpose_item(args.in[12], 256, 1024, Wukv_t, scr, r, X.lane); continue; } r -= I_UKV;
            if (r < I_O) { p0_transpose_item(args.in[15], 1024, 1024, Wo_t, scr, r, X.lane); continue; } r -= I_O;
            if (r < I_UP) { p0_transpose_item<true>(args.in[17], 1024, 5632, Wup_t, scr, r, X.lane); continue; } r -= I_UP;
            p0_transpose_item(args.in[19], 2816, 1024, Wdn_t, scr, r, X.lane);
        }
        { const u32x4 zero = {0u, 0u, 0u, 0u}; u32x4* p = (u32x4*)(Win_t + (size_t)2240 * 1024);
          for (int i = blockIdx.x * 512 + X.tid; i < 64 * 1024 / 8; i += X.G * 512) p[i] = zero; }
        for (int i = blockIdx.x * 512 + X.tid; i < 8192 * 32; i += X.G * 512) {
            const int pos = i >> 5, k = i & 31;
            const double inv = exp2(-(double)k * (13.287712379549449 / 32.0));
            const double rev = (double)pos * inv * 0.15915494309189535;
            const float fr = (float)(rev - floor(rev));
            cosT[i] = __builtin_amdgcn_cosf(fr); sinT[i] = __builtin_amdgcn_sinf(fr);
        }
    }
    grid.sync();
    modnorm_phase(X, x_p, x_s - (size_t)T_P * DM, args.in[6], mod, 0, 1024, H);
    xcd_barrier(bar);
    {
        pg8::Gemm g{H, Win_t, T_ALL, ZC, 1024}; pg8::StaticOrder S; S.init(T_ALL, ZC, X.G, (int)blockIdx.x, 1024);
        pg8::EpiBf16 E{Z, ZC};
#ifndef NO_BF
        pg8::gemm_phase<pg8::EpiBf16, pg8::StaticOrder, true, true>(X.lds, g, S, E);
#endif
    }
    xcd_barrier(bar);
    p3_phase(X, Z, args.in[8], args.in[13], args.in[9], args.in[11], cosT, sinT, YC, CQN, CKVN, KR);
    xcd_barrier(bar);
    {
        pg8::Gemm g{CQN, Wuq_t, T_ALL, 768, 384}; pg8::StaticOrder S; S.init(T_ALL, 768, X.G, (int)blockIdx.x, 384);
        pg8::EpiBf16 E{QB, 768};
#ifndef NO_BF
        pg8::gemm_phase<pg8::EpiBf16, pg8::StaticOrder, true, true>(X.lds, g, S, E);
#endif
    }
    {
        pg8::Gemm g{CKVN, Wukv_t, T_ALL, 1024, 256}; pg8::StaticOrder S; S.init(T_ALL, 1024, X.G, (int)blockIdx.x, 256);
        pg8::EpiBf16 E{KVB, 1024};
#ifndef NO_BF
        pg8::gemm_phase<pg8::EpiBf16, pg8::StaticOrder, true, true>(X.lds, g, S, E);
#endif
    }
    xcd_barrier(bar);
    {
        for (int L = X.vcu; L < 1536; L += X.G) {
            int rowbase, h, q0, seq;
            if (L < 1024) { const int bh = L >> 5, qb = L & 31; rowbase = T_P + (bh >> 2) * S_S; h = bh & 3; q0 = qb * 256; seq = S_S; }
            else { const int l2 = L - 1024; const int bh = l2 >> 3, qb = l2 & 7; rowbase = (bh >> 2) * S_P; h = bh & 3; q0 = qb * 256; seq = S_P; }
#ifndef NO_ATT
            att::attn_unit(QB + (size_t)(rowbase + q0) * 768 + h * 192, KVB + (size_t)rowbase * 1024 + h * 256, KVB + (size_t)rowbase * 1024 + h * 256 + 128,
                           KR + (size_t)rowbase * 64, YC + (size_t)(rowbase + q0) * 1024 + 512 + h * 128, cosT + q0 * 32, sinT + q0 * 32, seq, (char*)lds);
#endif
        }
    }
    xcd_barrier(bar);
    p5b_phase(X, YC, args.in[14]);
    xcd_barrier(bar);
    {
        pg8::Gemm g{YC, Wo_t, T_ALL, 1024, 1024}; pg8::StaticOrder S; S.init(T_ALL, 1024, X.G, (int)blockIdx.x, 1024);
        pg8::EpiRes E{x_p, x_s - (size_t)T_P * DM, out, mod, 2048, 0};
#ifndef NO_RES
        pg8::gemm_phase<pg8::EpiRes, pg8::StaticOrder, true, true>(X.lds, g, S, E);
#endif
    }
    xcd_barrier(bar);
    modnorm_phase(X, out, out, args.in[16], mod, 3072, 4096, H);
    xcd_barrier(bar);
    {
        pg8::Gemm g{H, Wup_t, T_ALL, UC, 1024}; pg8::StaticOrder S; S.init(T_ALL, UC, X.G, (int)blockIdx.x, 1024);
        pg8::EpiGate E{ACT, UB, args.in[18], (LAS pg8::f32x4*)(X.lds + 131072)};
        pg8::gemm_phase<pg8::EpiGate, pg8::StaticOrder, true, true>(X.lds, g, S, E);
    }
    xcd_barrier(bar);
    p9_fixup_phase(X, UB, args.in[18], ACT);
    xcd_barrier(bar);
    {
        pg8::Gemm g{ACT, Wdn_t, T_ALL, 1024, DFF}; pg8::SplitOrder S; S.init(T_ALL, 1024, X.G, (int)blockIdx.x, DFF, (int)((blockIdx.x >> 3) & 1));
        pg8::EpiRes E{out, out, out, mod, 5120, 0};
        pg8::gemm_phase<pg8::EpiRes, pg8::SplitOrder, true, true>(X.lds, g, S, E);
    }
    xcd_barrier(bar);
    final_norm_phase(X, out, args.in[20]);
}

extern "C" void kernel_launch(void* const* d_in, const int* in_sizes, int n_in, void* d_out, int out_size, void* d_ws, size_t ws_size, hipStream_t stream) {
    static int grid = 0;
    if (grid == 0) {
        if (n_in != 21 || out_size != T_ALL * DM || ws_size < WS_END) { fprintf(stderr, "kernel_launch: unexpected shapes: n_in %d out %d ws %zu (need %zu)\n", n_in, out_size, ws_size, (size_t)WS_END); grid = -1; return; }
        int dev = 0, cus = 0, per_cu = 0;
        hipGetDevice(&dev); hipDeviceGetAttribute(&cus, hipDeviceAttributeMultiprocessorCount, dev);
        if (hipFuncSetAttribute((const void*)fwd_kernel, hipFuncAttributeMaxDynamicSharedMemorySize, LDS_BYTES) != hipSuccess) { fprintf(stderr, "kernel_launch: hipFuncSetAttribute failed\n"); grid = -1; return; }
        if (hipOccupancyMaxActiveBlocksPerMultiprocessor(&per_cu, (const void*)fwd_kernel, 512, LDS_BYTES) != hipSuccess || per_cu < 1) { fprintf(stderr, "kernel_launch: occupancy query says %d\n", per_cu); per_cu = 1; }
        (void)hipGetLastError();
        grid = cus * per_cu;
    }
    if (grid < 0) return;
    if (hipMemsetAsync(d_ws, 0, 16384, stream) != hipSuccess) { fprintf(stderr, "kernel_launch: hipMemsetAsync failed\n"); return; }
    Args a{};
    for (int i = 0; i < 21; ++i) a.in[i] = (const float*)d_in[i];
    a.out = (float*)d_out; a.ws = (unsigned char*)d_ws;
    void* kargs[] = {&a};
    hipError_t e = hipLaunchCooperativeKernel((const void*)fwd_kernel, dim3(grid), dim3(512), kargs, LDS_BYTES, stream);
    if (e != hipSuccess) fprintf(stderr, "kernel_launch: cooperative launch failed: %s (grid %d)\n", hipGetErrorString(e), grid);
}
```

```cpp
#include <hip/hip_runtime.h>
#include <hip/hip_cooperative_groups.h>
#include <cstdio>
#include <cstdint>
namespace cg = cooperative_groups;
namespace pg8 {
#define PG8_LAS __attribute__((address_space(3)))
typedef unsigned short bf16_t;
typedef short bf16x8 __attribute__((ext_vector_type(8)));
typedef float f32x4 __attribute__((ext_vector_type(4)));
typedef unsigned u32x4 __attribute__((ext_vector_type(4)));
constexpr int BM = 256, BK = 64, HALF = 128, HTB = HALF * BK * 2  , STAGE_BYTES = 8 * HTB, NXCD = 8, WGM = 8;

__host__ __device__ __forceinline__ int lds_byte(int r, int c) { const int st = (r >> 4) * 2 + (c >> 5), rr = r & 15, cc = c & 31, ob = rr * 64 + cc * 2; return st * 1024 + (ob ^ (((ob >> 9) & 1) << 5)); }
__host__ __device__ __forceinline__ void stage_rc(int b, int& R, int& C) { const int st = b / 1024, sb = b % 1024, swz = sb ^ (((sb >> 9) & 1) << 5); R = (st >> 1) * 16 + swz / 64; C = (st & 1) * 32 + (swz % 64) / 2; }
__host__ __device__ __forceinline__ int perm32(int rho) { const int n = rho >> 4, i = rho & 15; return 8 * (i >> 2) + 4 * n + (i & 3); }

struct Unit { int pm, pn, koff, nt; };
struct Gemm { const bf16_t* A; const bf16_t* Bt; int M, N, K; };

struct StaticOrder {
    int nM, nN, nwg, G, c, ntk;
    __host__ __device__ void init(int M, int N, int G_, int c_, int K_) { nM = M / BM; nN = N / BM; nwg = nM * nN; G = G_; c = c_; ntk = K_ / BK; }
    __host__ __device__ bool next(int i, Unit& u) const {
        const long L = (long)i * G + c; if (L >= nwg) return false;
        int wgid = (int)L; { const int q = nwg / NXCD, r = nwg % NXCD, xcd = wgid % NXCD, off = wgid / NXCD; wgid = (xcd < r ? xcd * (q + 1) : r * (q + 1) + (xcd - r) * q) + off; }
        const int nig = WGM * nN, gid = wgid / nig, fm = gid * WGM, gsz = (nM - fm) < WGM ? (nM - fm) : WGM;
        u.pm = fm + ((wgid % nig) % gsz); u.pn = (wgid % nig) / gsz; u.koff = 0; u.nt = ntk; return true;
    }
    __device__ __forceinline__ void a_ready(const Unit&) const {}
    __device__ __forceinline__ void done(const Unit&) const {}
};

__device__ __forceinline__ unsigned cvt_pk_bf16(float lo, float hi) { unsigned r; asm volatile("v_cvt_pk_bf16_f32 %0, %1, %2" : "=v"(r) : "v"(lo), "v"(hi)); return r; }
typedef float f32x2 __attribute__((ext_vector_type(2)));
struct SplitOrder {
    StaticOrder S; int split, h0;
    __host__ __device__ void init(int M, int N, int G_, int c_, int K_, int split_) { S.init(M, N, G_, c_, K_); split = split_; h0 = ((K_ / BK) / 4) * 2; }
    __host__ __device__ bool next(int i, Unit& u) const {
        if (!split) return S.next(i, u);
        if (i == 0) { if (!S.next(0, u)) return false; u.nt = h0; return true; }
        if (i == 1) { if (!S.next(0, u)) return false; u.koff = h0 * BK; u.nt = S.ntk - h0; return true; }
        return S.next(i - 1, u);
    }
    __device__ __forceinline__ void a_ready(const Unit&) const {}
    __device__ __forceinline__ void done(const Unit&) const {}
};
struct EpiBf16 {
    static constexpr bool PERM = true, AFTER_DRAIN = false;
    bf16_t* O; int ldc;
    __device__ __forceinline__ void operator()(const f32x4 (&acc)[2][2][4][2], const Unit& u, int wr, int wc, int fr, int fq) const {
        const int row0 = u.pm * BM + wr * 64 + fr; const int col0 = u.pn * BM + wc * 32 + 8 * fq;
#pragma unroll
        for (int ai = 0; ai < 2; ++ai)
#pragma unroll
            for (int m = 0; m < 4; ++m) { bf16_t* rowp = O + (size_t)(row0 + ai * HALF + m * 16) * ldc + col0;
#pragma unroll
                for (int bj = 0; bj < 2; ++bj) { const f32x4 v0 = acc[ai][bj][m][0], v1 = acc[ai][bj][m][1];
                    u32x4 w; w.x = cvt_pk_bf16(v0[0], v0[1]); w.y = cvt_pk_bf16(v0[2], v0[3]); w.z = cvt_pk_bf16(v1[0], v1[1]); w.w = cvt_pk_bf16(v1[2], v1[3]);
                    *(u32x4*)(rowp + bj * HALF) = w; } }
    }
};
struct EpiRes {
    static constexpr bool PERM = false, AFTER_DRAIN = false;
    const float* base_p; const float* base_s;
    float* out; const float* mod; int gate_off; int row_off;
    __device__ __forceinline__ void operator()(const f32x4 (&acc)[2][2][4][2], const Unit& u, int wr, int wc, int fr, int fq) const {
        const int t0 = row_off + u.pm * BM;
        const int bi = t0 < 32768 ? (t0 >> 11) : 16 + ((t0 - 32768) >> 13);
        const float* base = t0 < 32768 ? base_p : base_s;
        const float* gp = mod + bi * 6144 + gate_off;
        const int col0 = u.pn * BM + wc * 32 + 4 * fq;
        f32x4 gv[2][2];
#pragma unroll
        for (int bj = 0; bj < 2; ++bj)
#pragma unroll
            for (int n = 0; n < 2; ++n) gv[bj][n] = *(const f32x4*)(gp + col0 + bj * HALF + n * 16);
#pragma unroll
        for (int ai = 0; ai < 2; ++ai)
#pragma unroll
            for (int m = 0; m < 4; ++m) { const size_t off = (size_t)(t0 + ai * HALF + wr * 64 + m * 16 + fr) * 1024 + col0;
#pragma unroll
                for (int bj = 0; bj < 2; ++bj)
#pragma unroll
                    for (int n = 0; n < 2; ++n) { const f32x4 bs = *(const f32x4*)(base + off + bj * HALF + n * 16);
                        *(f32x4*)(out + off + bj * HALF + n * 16) = bs + gv[bj][n] * acc[ai][bj][m][n]; } }
    }
};

__device__ __forceinline__ float dpp_ror1(float x) { return __builtin_bit_cast(float, __builtin_amdgcn_update_dpp(0, __builtin_bit_cast(int, x), 0x121, 0xf, 0xf, false)); }
__device__ __forceinline__ float dpp_ror15(float x) { return __builtin_bit_cast(float, __builtin_amdgcn_update_dpp(0, __builtin_bit_cast(int, x), 0x12F, 0xf, 0xf, false)); }
struct EpiGate {
    static constexpr bool PERM = false, AFTER_DRAIN = false;
    bf16_t* ACT; bf16_t* UB; const float* cw; PG8_LAS f32x4* xl;
    static __device__ __forceinline__ int xi(int ai, int wr, int which, int wc, int bj, int n, int fq) { return (((((ai * 2 + wr) * 2 + which) * 4 + wc) * 2 + bj) * 2 + n) * 4 + fq; }
    __device__ __forceinline__ void operator()(const f32x4 (&acc)[2][2][4][2], const Unit& u, int wr, int wc, int fr, int fq) const {
        typedef unsigned u32x2v __attribute__((ext_vector_type(2)));
        const int colg = u.pn * 128 + wc * 32 + 4 * fq;
        if (fr == 0) {
#pragma unroll
            for (int ai = 0; ai < 2; ++ai)
#pragma unroll
                for (int bj = 0; bj < 2; ++bj)
#pragma unroll
                    for (int n = 0; n < 2; ++n) xl[xi(ai, wr, 0, wc, bj, n, fq)] = acc[ai][bj][0][n];
        }
        if (fr == 15) {
#pragma unroll
            for (int ai = 0; ai < 2; ++ai)
#pragma unroll
                for (int bj = 0; bj < 2; ++bj)
#pragma unroll
                    for (int n = 0; n < 2; ++n) xl[xi(ai, wr, 1, wc, bj, n, fq)] = acc[ai][bj][3][n];
        }
        if (wr == 0 && fr < 2) {
#pragma unroll
            for (int bj = 0; bj < 2; ++bj)
#pragma unroll
                for (int n = 0; n < 2; ++n) { const f32x4 v = acc[0][bj][0][n]; u32x2v w; w.x = cvt_pk_bf16(v[0], v[1]); w.y = cvt_pk_bf16(v[2], v[3]);
                    *(u32x2v*)(UB + ((size_t)u.pm * 4 + fr) * 5632 + bj * 2816 + colg + 16 * n) = w; }
        }
        if (wr == 1 && fr >= 14) {
#pragma unroll
            for (int bj = 0; bj < 2; ++bj)
#pragma unroll
                for (int n = 0; n < 2; ++n) { const f32x4 v = acc[1][bj][3][n]; u32x2v w; w.x = cvt_pk_bf16(v[0], v[1]); w.y = cvt_pk_bf16(v[2], v[3]);
                    *(u32x2v*)(UB + ((size_t)u.pm * 4 + (fr - 12)) * 5632 + bj * 2816 + colg + 16 * n) = w; }
        }
        f32x4 w[3][2];
#pragma unroll
        for (int k = 0; k < 3; ++k)
#pragma unroll
            for (int bj = 0; bj < 2; ++bj) w[k][bj] = *(const f32x4*)(cw + k * 5632 + bj * 2816 + colg);
        asm volatile("s_waitcnt lgkmcnt(0)\n\ts_barrier" ::: "memory");
#pragma unroll
        for (int n = 0; n < 2; ++n) {
            if (n == 1) {
#pragma unroll
                for (int k = 0; k < 3; ++k)
#pragma unroll
                    for (int bj = 0; bj < 2; ++bj) w[k][bj] = *(const f32x4*)(cw + k * 5632 + bj * 2816 + colg + 16);
            }
#pragma unroll
            for (int ai = 0; ai < 2; ++ai) {
                const int pai = wr == 1 ? ai : (ai > 0 ? ai - 1 : 0), pwr = wr ^ 1;
                const int nai = wr == 0 ? ai : (ai < 1 ? ai + 1 : 1), nwr = wr ^ 1;
                f32x4 pvf[2], nxl[2];
#pragma unroll
                for (int bj = 0; bj < 2; ++bj) { pvf[bj] = xl[xi(pai, pwr, 1, wc, bj, n, fq)]; nxl[bj] = xl[xi(nai, nwr, 0, wc, bj, n, fq)]; }
#pragma unroll
                for (int m = 0; m < 4; ++m) {
                    const int row = ai * HALF + wr * 64 + m * 16 + fr;
                    f32x4 cv[2];
#pragma unroll
                    for (int bj = 0; bj < 2; ++bj) {
                        const f32x4 cur = acc[ai][bj][m][n];
                        const f32x4 pr = m > 0 ? acc[ai][bj][m > 0 ? m - 1 : 0][n] : pvf[bj];
                        const f32x4 nr = m < 3 ? acc[ai][bj][m < 3 ? m + 1 : 3][n] : nxl[bj];
                        const f32x4 mixp = fr == 15 ? pr : cur, mixn = fr == 0 ? nr : cur;
                        const f32x4 rp = {dpp_ror1(mixp[0]), dpp_ror1(mixp[1]), dpp_ror1(mixp[2]), dpp_ror1(mixp[3])};
                        const f32x4 rn = {dpp_ror15(mixn[0]), dpp_ror15(mixn[1]), dpp_ror15(mixn[2]), dpp_ror15(mixn[3])};
                        f32x4 c = w[1][bj] * cur;
                        c = rp * w[0][bj] + c;
                        c = rn * w[2][bj] + c;
                        cv[bj] = c;
                    }
                    const f32x4 t = cv[0] * (-1.4426950408889634f);
                    f32x4 d = {__builtin_amdgcn_exp2f(t[0]), __builtin_amdgcn_exp2f(t[1]), __builtin_amdgcn_exp2f(t[2]), __builtin_amdgcn_exp2f(t[3])};
                    d = d + 1.0f;
                    const f32x4 r = {__builtin_amdgcn_rcpf(d[0]), __builtin_amdgcn_rcpf(d[1]), __builtin_amdgcn_rcpf(d[2]), __builtin_amdgcn_rcpf(d[3])};
                    const f32x4 o = (cv[0] * cv[1]) * r;
                    { u32x2v pk; pk.x = cvt_pk_bf16(o[0], o[1]); pk.y = cvt_pk_bf16(o[2], o[3]);
                        *(u32x2v*)(ACT + (size_t)(u.pm * BM + row) * 2816 + colg + 16 * n) = pk; }
                    if (m & 1) __builtin_amdgcn_sched_barrier(0);
                }
            }
        }
    }
};

template <class Epi, class Sched, bool ALIGN_EPI = false, bool SP2 = false>
__device__ __forceinline__ void gemm_phase(PG8_LAS unsigned char* lds, const Gemm g, const Sched& S, const Epi& E) {
    int tid_ = threadIdx.x; asm volatile("" : "+v"(tid_));
    const int tid = tid_, wid = __builtin_amdgcn_readfirstlane(tid >> 6), lane = tid & 63, wr = wid >> 2, wc = wid & 3, fr = lane & 15, fq = lane >> 4;
    const int K = g.K, nt = K / BK;
    unsigned voffA[2], voffB[2];
#pragma unroll
    for (int i = 0; i < 2; ++i) { int R, C; stage_rc(tid * 16 + i * 8192, R, C); const int Rb = Epi::PERM ? ((R & ~31) + perm32(R & 31)) : R;
        voffA[i] = (unsigned)(R * K + C) * 2u; voffB[i] = (unsigned)(Rb * K + C) * 2u; }
    const size_t kstep = (size_t)(BK * 2);
    const size_t hstep = (size_t)HALF * K * 2;
    const size_t tstep = 2 * hstep;
    const unsigned ldsw = (unsigned)wid * 1024u;
    const int aoff = lds_byte(wr * 64 + fr, fq * 8), boff = lds_byte(wc * 32 + fr, fq * 8);
#define PG8_SA(b, h) (((b) * 2 + (h)) * HTB)
#define PG8_SB(b, h) ((4 + (b) * 2 + (h)) * HTB)
#define PG8_STAGE(bufoff, gbase, voff) do { _Pragma("unroll") for (int _i = 0; _i < 2; ++_i) \
        __builtin_amdgcn_global_load_lds((const unsigned*)((const char*)(gbase) + (voff)[_i]), (PG8_LAS unsigned*)(lds + (bufoff) + ldsw + _i * 8192), 16, 0, 0); } while (0)
#define PG8_LDA(dst, b, h) do { _Pragma("unroll") for (int m = 0; m < 4; ++m) _Pragma("unroll") for (int k = 0; k < 2; ++k) dst[m][k] = *(const PG8_LAS bf16x8*)(lds + PG8_SA(b, h) + aoff + m * 2048 + k * 1024); } while (0)
#define PG8_LDB(dst, b, h) do { _Pragma("unroll") for (int n = 0; n < 2; ++n) _Pragma("unroll") for (int k = 0; k < 2; ++k) dst[n][k] = *(const PG8_LAS bf16x8*)(lds + PG8_SB(b, h) + boff + n * 2048 + k * 1024); } while (0)
#define PG8_MMA(ai, bj, At, Bt) do { __builtin_amdgcn_s_setprio(1); _Pragma("unroll") for (int m = 0; m < 4; ++m) _Pragma("unroll") for (int n = 0; n < 2; ++n) _Pragma("unroll") for (int k = 0; k < 2; ++k) \
        acc[ai][bj][m][n] = __builtin_amdgcn_mfma_f32_16x16x32_bf16(Bt[n][k], At[m][k], acc[ai][bj][m][n], 0, 0, 0); __builtin_amdgcn_s_setprio(0); } while (0)
#define PG8_WAIT_V(n) asm volatile("s_waitcnt vmcnt(" #n ")" ::: "memory")
#define PG8_WAIT_L(n) asm volatile("s_waitcnt lgkmcnt(" #n ")" ::: "memory")
#define PG8_BAR __builtin_amdgcn_s_barrier()
#define PG8_SCHED __builtin_amdgcn_sched_barrier(0)
    Unit cur, nxt; int ui = 0;
    if (!S.next(0, cur)) return;
    f32x4 acc[2][2][4][2];
#pragma unroll
    for (int a = 0; a < 2; ++a)
#pragma unroll
        for (int b = 0; b < 2; ++b)
#pragma unroll
            for (int m = 0; m < 4; ++m)
#pragma unroll
                for (int n = 0; n < 2; ++n) acc[a][b][m][n] = (f32x4){0.f, 0.f, 0.f, 0.f};
    bf16x8 At[4][2], B0[2][2], B1[2][2];
    const char* cA = (const char*)g.A + (size_t)cur.pm * tstep + (size_t)cur.koff * 2; const char* cB = (const char*)g.Bt + (size_t)cur.pn * tstep + (size_t)cur.koff * 2;
    S.a_ready(cur);
    if constexpr (SP2) {
        PG8_STAGE(PG8_SB(0, 0), cB, voffB); PG8_STAGE(PG8_SB(0, 1), cB + hstep, voffB); PG8_STAGE(PG8_SA(0, 0), cA, voffA); PG8_STAGE(PG8_SA(0, 1), cA + hstep, voffA);
        if (wr == 1) PG8_BAR;
        PG8_WAIT_V(2); PG8_BAR;
        PG8_STAGE(PG8_SB(1, 0), cB + kstep, voffB); PG8_STAGE(PG8_SA(1, 0), cA + kstep, voffA); PG8_STAGE(PG8_SB(1, 1), cB + hstep + kstep, voffB);
        PG8_WAIT_V(6); PG8_BAR;
    } else {
        PG8_STAGE(PG8_SB(0, 0), cB, voffB); PG8_STAGE(PG8_SA(0, 0), cA, voffA); PG8_STAGE(PG8_SB(0, 1), cB + hstep, voffB); PG8_STAGE(PG8_SA(0, 1), cA + hstep, voffA);
        if (wr == 1) PG8_BAR;
        PG8_WAIT_V(4); PG8_BAR;
        PG8_STAGE(PG8_SB(1, 0), cB + kstep, voffB); PG8_STAGE(PG8_SA(1, 0), cA + kstep, voffA); PG8_STAGE(PG8_SB(1, 1), cB + hstep + kstep, voffB);
        PG8_WAIT_V(6); PG8_BAR;
    }
    for (;;) {
        const bool has_next = S.next(ui + 1, nxt);
        const char* nA = has_next ? (const char*)g.A + (size_t)nxt.pm * tstep + (size_t)nxt.koff * 2 : cA; const char* nB = has_next ? (const char*)g.Bt + (size_t)nxt.pn * tstep + (size_t)nxt.koff * 2 : cB;
        const int nt_u = cur.nt;
        for (int t = 0; t < nt_u; t += 2) {
            const bool last = (t == nt_u - 2);
            const char* a1 = cA + (size_t)(t + 1) * kstep;
            const char* a2 = last ? nA : cA + (size_t)(t + 2) * kstep; const char* b2 = last ? nB : cB + (size_t)(t + 2) * kstep;
            const char* a3 = a2 + kstep; const char* b3 = b2 + kstep;
            if (last && has_next) S.a_ready(nxt);
            if constexpr (SP2) {
            PG8_LDB(B0, 0, 0); PG8_LDB(B1, 0, 1); PG8_SCHED; PG8_LDA(At, 0, 0); PG8_STAGE(PG8_SA(1, 1), a1 + hstep, voffA);
            PG8_WAIT_V(8); PG8_WAIT_L(0); PG8_BAR; PG8_MMA(0, 0, At, B0); PG8_MMA(0, 1, At, B1); PG8_BAR; PG8_SCHED;
            PG8_LDA(At, 0, 1); PG8_STAGE(PG8_SB(0, 0), b2, voffB); PG8_STAGE(PG8_SB(0, 1), b2 + hstep, voffB); PG8_STAGE(PG8_SA(0, 0), a2, voffA);
            PG8_WAIT_V(8); PG8_WAIT_L(0); PG8_BAR; PG8_MMA(1, 0, At, B0); PG8_MMA(1, 1, At, B1); PG8_BAR; PG8_SCHED;
            PG8_LDB(B0, 1, 0); PG8_LDB(B1, 1, 1); PG8_SCHED; PG8_LDA(At, 1, 0); PG8_STAGE(PG8_SA(0, 1), a2 + hstep, voffA);
            PG8_WAIT_V(8); PG8_WAIT_L(0); PG8_BAR; PG8_MMA(0, 0, At, B0); PG8_MMA(0, 1, At, B1); PG8_BAR; PG8_SCHED;
            PG8_LDA(At, 1, 1); PG8_STAGE(PG8_SB(1, 0), b3, voffB); PG8_STAGE(PG8_SB(1, 1), b3 + hstep, voffB); PG8_STAGE(PG8_SA(1, 0), a3, voffA);
            PG8_WAIT_V(8); PG8_WAIT_L(0); PG8_BAR; PG8_MMA(1, 0, At, B0); PG8_MMA(1, 1, At, B1); PG8_BAR; PG8_SCHED;
            } else {
            PG8_LDB(B0, 0, 0); PG8_SCHED; PG8_LDA(At, 0, 0); PG8_STAGE(PG8_SA(1, 1), a1 + hstep, voffA);
            PG8_WAIT_L(8); PG8_BAR; PG8_WAIT_L(0); PG8_MMA(0, 0, At, B0); PG8_BAR; PG8_SCHED;
            PG8_LDB(B1, 0, 1); PG8_STAGE(PG8_SB(0, 0), b2, voffB);
            PG8_BAR; PG8_WAIT_L(0); PG8_MMA(0, 1, At, B1); PG8_BAR;
            PG8_LDA(At, 0, 1); PG8_STAGE(PG8_SA(0, 0), a2, voffA);
            PG8_BAR; PG8_WAIT_L(0); PG8_MMA(1, 0, At, B0); PG8_BAR; PG8_SCHED;
            PG8_STAGE(PG8_SB(0, 1), b2 + hstep, voffB);
            PG8_WAIT_V(6); PG8_BAR; PG8_MMA(1, 1, At, B1); PG8_BAR;
            PG8_LDB(B0, 1, 0); PG8_SCHED; PG8_LDA(At, 1, 0); PG8_STAGE(PG8_SA(0, 1), a2 + hstep, voffA);
            PG8_WAIT_L(8); PG8_BAR; PG8_WAIT_L(0); PG8_MMA(0, 0, At, B0); PG8_BAR; PG8_SCHED;
            PG8_LDB(B1, 1, 1); PG8_STAGE(PG8_SB(1, 0), b3, voffB);
            PG8_BAR; PG8_WAIT_L(0); PG8_MMA(0, 1, At, B1); PG8_BAR;
            PG8_LDA(At, 1, 1); PG8_STAGE(PG8_SA(1, 0), a3, voffA);
            PG8_BAR; PG8_WAIT_L(0); PG8_MMA(1, 0, At, B0); PG8_BAR; PG8_SCHED;
            PG8_STAGE(PG8_SB(1, 1), b3 + hstep, voffB);
            PG8_WAIT_V(6); PG8_BAR; PG8_MMA(1, 1, At, B1); PG8_BAR;
            }
        }
        if constexpr (ALIGN_EPI) { if (wr == 0) PG8_BAR; }
        if constexpr (!Epi::AFTER_DRAIN) { E(acc, cur, wr, wc, fr, fq); S.done(cur); }
        if (!has_next) break;
#pragma unroll
        for (int a = 0; a < 2; ++a)
#pragma unroll
            for (int b = 0; b < 2; ++b)
#pragma unroll
                for (int m = 0; m < 4; ++m)
#pragma unroll
                    for (int n = 0; n < 2; ++n) acc[a][b][m][n] = (f32x4){0.f, 0.f, 0.f, 0.f};
        cur = nxt; cA = nA; cB = nB; ++ui;
        if constexpr (ALIGN_EPI) { if (wr == 1) PG8_BAR; }
    }
    PG8_WAIT_V(0);
    if constexpr (!ALIGN_EPI) { if (wr == 0) PG8_BAR; }
    PG8_BAR;
    if constexpr (Epi::AFTER_DRAIN) { E.fused(acc, cur, wr, wc, fr, fq, lds, wid, lane); S.done(cur); }
#undef PG8_SA
#undef PG8_SB
#undef PG8_STAGE
#undef PG8_LDA
#undef PG8_LDB
#undef PG8_MMA
#undef PG8_WAIT_V
#undef PG8_WAIT_L
#undef PG8_BAR
#undef PG8_SCHED
}
}

constexpr int DM = 1024, T_P = 32768, T_ALL = 98304, S_P = 2048, S_S = 8192;
constexpr int ZC = 2304;
constexpr int DFF = 2816, UC = 2 * DFF;
constexpr float EPS = 1e-6f;
constexpr int NWAVES = 8;
constexpr int FFN_CHUNK = 32768, N_FFN_CHUNKS = 3;

#define LAS __attribute__((address_space(3)))
typedef unsigned short bf16_t;
typedef short bf16x8 __attribute__((ext_vector_type(8)));
typedef short s16x4 __attribute__((ext_vector_type(4)));
typedef float f32x4 __attribute__((ext_vector_type(4)));
typedef float f32x16 __attribute__((ext_vector_type(16)));
typedef unsigned u32x4 __attribute__((ext_vector_type(4)));
typedef unsigned u32x2 __attribute__((ext_vector_type(2)));

constexpr size_t MiB = 1u << 20;
constexpr size_t WS_MOD = 1 * MiB, WS_COS = 2 * MiB, WS_SIN = 3 * MiB;
constexpr size_t WS_WIN = 4 * MiB, WS_WUQ = 9 * MiB, WS_WUKV = 10 * MiB, WS_WO = 11 * MiB, WS_WUP = 13 * MiB, WS_WDN = 24 * MiB;
constexpr size_t WS_H = 32 * MiB;
constexpr size_t WS_Z = 224 * MiB;
constexpr size_t WS_QB = 224 * MiB, WS_KVB = 368 * MiB;
constexpr size_t WS_CQN = 656 * MiB, WS_CKVN = 728 * MiB, WS_KR = 776 * MiB;
constexpr size_t WS_YC = 788 * MiB;
constexpr size_t WS_ACT = 224 * MiB, WS_UB = 760 * MiB;
constexpr size_t WS_U_UNUSED = 0;
constexpr size_t WS_END = 980 * MiB;

constexpr int LDS_BYTES = 163840;

__device__ __forceinline__ float bf2f(unsigned short u) { return __uint_as_float((unsigned)u << 16); }
__device__ __forceinline__ float bflo(unsigned w) { return __uint_as_float(w << 16); }
__device__ __forceinline__ float bfhi(unsigned w) { return __uint_as_float(w & 0xffff0000u); }
__device__ __forceinline__ unsigned cvtpk(float lo, float hi) { unsigned r; asm volatile("v_cvt_pk_bf16_f32 %0, %1, %2" : "=v"(r) : "v"(lo), "v"(hi)); return r; }
__device__ __forceinline__ float wave_sum(float v) {
#define WS_DPP(x, ctrl, rmask) __builtin_bit_cast(float, __builtin_amdgcn_update_dpp(0, __builtin_bit_cast(int, (x)), (ctrl), (rmask), 0xf, false))
    v += WS_DPP(v, 0xB1, 0xf);
    v += WS_DPP(v, 0x4E, 0xf);
    v += WS_DPP(v, 0x141, 0xf);
    v += WS_DPP(v, 0x140, 0xf);
    v += WS_DPP(v, 0x142, 0xa);
    v += WS_DPP(v, 0x143, 0xc);
#undef WS_DPP
    return __builtin_bit_cast(float, __builtin_amdgcn_readlane(__builtin_bit_cast(int, v), 63));
}
__device__ __forceinline__ void unpack8(const u32x4 w, float* f) {
    f[0] = bflo(w.x); f[1] = bfhi(w.x); f[2] = bflo(w.y); f[3] = bfhi(w.y); f[4] = bflo(w.z); f[5] = bfhi(w.z); f[6] = bflo(w.w); f[7] = bfhi(w.w);
}
__device__ __forceinline__ u32x4 pack8(const float* f) {
    u32x4 w; w.x = cvtpk(f[0], f[1]); w.y = cvtpk(f[2], f[3]); w.z = cvtpk(f[4], f[5]); w.w = cvtpk(f[6], f[7]); return w;
}

namespace att {
constexpr float SCALE = 0.07216878364870322f;
constexpr float THR = 8.f;
constexpr float QC = SCALE * 1.4426950408889634f;
constexpr int SHM_V = 16384, SHM_K = 16384, SHM_KR = 8192;
constexpr int OFF_K = 0, OFF_KR = 3 * SHM_K, OFF_V = OFF_KR + 3 * SHM_KR, OFF_WS = OFF_V + 3 * SHM_V, OFF_QR = OFF_WS + 8 * 256, ATT_LDS = OFF_QR + 8 * 4096;
__device__ __forceinline__ void glds16(const void* gsrc, unsigned lds_dst) { unsigned keep;
    asm volatile("s_mov_b32 %0, m0\n\ts_mov_b32 m0, %2\n\ts_nop 0\n\tglobal_load_lds_dwordx4 %1, off\n\ts_mov_b32 m0, %0" : "=&s"(keep) : "v"(gsrc), "s"(lds_dst) : "memory"); }
#define KSWZ(row, colB) ((row) * 256 + ((colB) ^ (((row) & 15) << 4)))
#define KRSWZ(row, colB) ((row) * 128 + ((colB) ^ ((((row) >> 1) & 7) << 4)))
#define SBAR() __builtin_amdgcn_sched_barrier(0)
__device__ __forceinline__ int crow(int r, int hi) { return (r & 3) + 8 * (r >> 2) + 4 * hi; }

__device__ __forceinline__ void partialSM(f32x16& p0, f32x16& p1, float& m_ref, f32x16& negm, float& alpha, bool first) {
    constexpr float THR2 = THR * 1.4426950408889634f;
    float ma = p0[0], mb = p0[8], mc = p1[0], md = p1[8];
#pragma unroll
    for (int r = 1; r < 8; ++r) { ma = fmaxf(ma, p0[r]); mb = fmaxf(mb, p0[8 + r]); mc = fmaxf(mc, p1[r]); md = fmaxf(md, p1[8 + r]); }
    float pmax = fmaxf(fmaxf(ma, mb), fmaxf(mc, md));
    { auto rr = __builtin_amdgcn_permlane32_swap(__float_as_uint(pmax), __float_as_uint(pmax), false, false);
      pmax = fmaxf(__uint_as_float(rr[0]), __uint_as_float(rr[1])); }
    if (__builtin_expect(!first && __all(pmax <= THR2), 1)) { alpha = 1.f; }
    else { const float d = first ? pmax : fmaxf(pmax, 0.f); m_ref += d; alpha = first ? 1.f : __builtin_amdgcn_exp2f(-d);
#pragma unroll
        for (int r = 0; r < 16; ++r) { p0[r] -= d; p1[r] -= d; }
#pragma unroll
        for (int r = 0; r < 16; ++r) negm[r] = -m_ref; }
#pragma unroll
    for (int r = 0; r < 16; ++r) p0[r] = __builtin_amdgcn_exp2f(p0[r]);
}
__device__ __forceinline__ void finishSM(f32x16& p0, f32x16& p1, float alpha, float& l_reg, bf16x8& pa0, bf16x8& pa1, bf16x8& pa2, bf16x8& pa3) {
#pragma unroll
    for (int r = 0; r < 16; ++r) p1[r] = __builtin_amdgcn_exp2f(p1[r]);
    float sa = p0[0], sb = p0[8], sc = p1[0], sd = p1[8];
#pragma unroll
    for (int r = 1; r < 8; ++r) { sa += p0[r]; sb += p0[8 + r]; sc += p1[r]; sd += p1[8 + r]; }
    float ps = (sa + sb) + (sc + sd);
    { auto rr = __builtin_amdgcn_permlane32_swap(__float_as_uint(ps), __float_as_uint(ps), false, false);
      ps = __uint_as_float(rr[0]) + __uint_as_float(rr[1]); }
    l_reg = l_reg * alpha + ps;
#define PK4(P, BASE, OUT) do { unsigned a0 = cvtpk(P[BASE + 0], P[BASE + 1]), a1 = cvtpk(P[BASE + 2], P[BASE + 3]);   \
    unsigned b0 = cvtpk(P[BASE + 4], P[BASE + 5]), b1 = cvtpk(P[BASE + 6], P[BASE + 7]);                              \
    auto r0 = __builtin_amdgcn_permlane32_swap(a0, b0, false, false); auto r1 = __builtin_amdgcn_permlane32_swap(a1, b1, false, false); \
    u32x4 w = {r0[0], r1[0], r0[1], r1[1]}; OUT = *reinterpret_cast<bf16x8*>(&w); } while (0)
    PK4(p0, 0, pa0); PK4(p0, 8, pa1); PK4(p1, 0, pa2); PK4(p1, 8, pa3);
#undef PK4
}
__device__ __forceinline__ void qkt(f32x16& p0, f32x16& p1, const char* Ks, const char* Krs, const bf16x8* qr, const char* qro, int r32, int hi, const f32x16& negm) {
    p0 = negm; p1 = negm;
#pragma unroll
    for (int d0 = 0; d0 < 8; ++d0) { const int cb = (d0 * 16 + hi * 8) * 2;
        const bf16x8 b0 = *reinterpret_cast<const bf16x8*>(Ks + KSWZ(r32, cb));
        const bf16x8 b1 = *reinterpret_cast<const bf16x8*>(Ks + KSWZ(32 + r32, cb));
        p0 = __builtin_amdgcn_mfma_f32_32x32x16_bf16(b0, qr[d0], p0, 0, 0, 0);
        p1 = __builtin_amdgcn_mfma_f32_32x32x16_bf16(b1, qr[d0], p1, 0, 0, 0); }
#pragma unroll
    for (int d0 = 0; d0 < 4; ++d0) { const int cb = (d0 * 16 + hi * 8) * 2;
        const bf16x8 b0 = *reinterpret_cast<const bf16x8*>(Krs + KRSWZ(r32, cb));
        const bf16x8 b1 = *reinterpret_cast<const bf16x8*>(Krs + KRSWZ(32 + r32, cb));
        const bf16x8 qf = qr[8 + d0];
        p0 = __builtin_amdgcn_mfma_f32_32x32x16_bf16(b0, qf, p0, 0, 0, 0);
        p1 = __builtin_amdgcn_mfma_f32_32x32x16_bf16(b1, qf, p1, 0, 0, 0); }
}
__device__ __forceinline__ int v_st(int k, int c) { const int kk = (k & ~0xC) | ((k & 4) << 1) | ((k & 8) >> 1); return ((kk >> 3) * 4 + (c >> 5)) * 512 + ((kk & 7) * 32 + (c & 31)) * 2; }
__device__ __forceinline__ int v_rd_base(int lane) { return ((lane & 3) << 3) | (((lane >> 2) & 3) << 6) | (((lane >> 4) & 1) << 5) | (((lane >> 5) & 1) << 8); }
constexpr int v_rd_off(int d0, int ks, int half) { return d0 * 512 + ks * 4096 + half * 2048; }
template <int OFF> __device__ __forceinline__ s16x4 tr_read(int vb) {
    s16x4 r; asm volatile("ds_read_b64_tr_b16 %0, %1 offset:%2" : "=&v"(r) : "v"(vb), "i"(OFF) : "memory"); return r;
}
template <int D0> __device__ __forceinline__ void pv_one(f32x16& od, int vb, bf16x8 pa0, bf16x8 pa1, bf16x8 pa2, bf16x8 pa3) {
    const s16x4 l0 = tr_read<v_rd_off(D0, 0, 0)>(vb), h0 = tr_read<v_rd_off(D0, 0, 1)>(vb), l1 = tr_read<v_rd_off(D0, 1, 0)>(vb), h1 = tr_read<v_rd_off(D0, 1, 1)>(vb);
    const s16x4 l2 = tr_read<v_rd_off(D0, 2, 0)>(vb), h2 = tr_read<v_rd_off(D0, 2, 1)>(vb), l3 = tr_read<v_rd_off(D0, 3, 0)>(vb), h3 = tr_read<v_rd_off(D0, 3, 1)>(vb);
    asm volatile("s_waitcnt lgkmcnt(0)" ::: "memory"); SBAR();
#define PK(L, H) (bf16x8){L[0], L[1], L[2], L[3], H[0], H[1], H[2], H[3]}
    od = __builtin_amdgcn_mfma_f32_32x32x16_bf16(pa0, PK(l0, h0), od, 0, 0, 0);
    od = __builtin_amdgcn_mfma_f32_32x32x16_bf16(pa1, PK(l1, h1), od, 0, 0, 0);
    od = __builtin_amdgcn_mfma_f32_32x32x16_bf16(pa2, PK(l2, h2), od, 0, 0, 0);
    od = __builtin_amdgcn_mfma_f32_32x32x16_bf16(pa3, PK(l3, h3), od, 0, 0, 0);
#undef PK
}
__device__ __forceinline__ void pv_d0(f32x16* o, int vb, bf16x8 pa0, bf16x8 pa1, bf16x8 pa2, bf16x8 pa3) {
    pv_one<0>(o[0], vb, pa0, pa1, pa2, pa3); pv_one<1>(o[1], vb, pa0, pa1, pa2, pa3); pv_one<2>(o[2], vb, pa0, pa1, pa2, pa3); pv_one<3>(o[3], vb, pa0, pa1, pa2, pa3);
}

__device__ __forceinline__ void attn_unit(const bf16_t* __restrict__ Qb, const bf16_t* __restrict__ Kh, const bf16_t* __restrict__ Vh, const bf16_t* __restrict__ Krh,
                                          bf16_t* __restrict__ Ob, const float* __restrict__ cosq, const float* __restrict__ sinq, int seq, char* lds) {
    int tid_ = threadIdx.x; asm volatile("" : "+v"(tid_));
    const int tid = tid_, wid = tid >> 6, lane = tid & 63, r32 = lane & 31, hi = lane >> 5;
    char* V_lds = lds + OFF_V; char* K_lds = lds + OFF_K; char* Kr_lds = lds + OFF_KR;
    float* ws = (float*)(lds + OFF_WS) + wid * 64; float* li_l = ws; float* al_l = ws + 32;
    float m_reg = 0.f, l_reg = 0; f32x16 negm = {}; f32x16 o[4] = {}; bf16x8 qr[12];
    const char* qro = nullptr;
    const bf16_t* Qw = Qb + (long)(wid * 32 + r32) * 768 + hi * 8;
#pragma unroll
    for (int d0 = 0; d0 < 8; ++d0) { float qf_[8]; unpack8(*reinterpret_cast<const u32x4*>(Qw + d0 * 16), qf_);
#pragma unroll
        for (int j = 0; j < 8; ++j) qf_[j] *= QC;
        qr[d0] = __builtin_bit_cast(bf16x8, pack8(qf_)); }
    {
        const float* cp = cosq + (wid * 32 + r32) * 32 + hi * 8; const float* sp = sinq + (wid * 32 + r32) * 32 + hi * 8;
#pragma unroll
        for (int g = 0; g < 2; ++g) {
            float c[8], s[8], x1[8], x2[8], y1[8], y2[8];
            *(f32x4*)&c[0] = *(const f32x4*)(cp + g * 16); *(f32x4*)&c[4] = *(const f32x4*)(cp + g * 16 + 4);
            *(f32x4*)&s[0] = *(const f32x4*)(sp + g * 16); *(f32x4*)&s[4] = *(const f32x4*)(sp + g * 16 + 4);
            unpack8(*reinterpret_cast<const u32x4*>(Qw + (8 + g) * 16), x1); unpack8(*reinterpret_cast<const u32x4*>(Qw + (10 + g) * 16), x2);
#pragma unroll
            for (int j = 0; j < 8; ++j) { y1[j] = (x1[j] * c[j] - x2[j] * s[j]) * QC; y2[j] = (x2[j] * c[j] + x1[j] * s[j]) * QC; }
            qr[8 + g] = __builtin_bit_cast(bf16x8, pack8(y1)); qr[10 + g] = __builtin_bit_cast(bf16x8, pack8(y2));
        }
    }
    const bf16_t* ksrc[2]; const bf16_t* vsrc[2]; const bf16_t* krsrc;
#pragma unroll
    for (int i = 0; i < 2; ++i) { const int p = (wid * 2 + i) * 64 + lane;
        { const int row = p >> 4, c = (p & 15) ^ (row & 15); ksrc[i] = Kh + (long)row * 1024 + c * 8; }
        { const int s = p >> 5, q = p & 31, kk = (s >> 2) * 8 + (q >> 2), k = (kk & ~0xC) | ((kk & 4) << 1) | ((kk & 8) >> 1), c = (s & 3) * 32 + (q & 3) * 8; vsrc[i] = Vh + (long)k * 1024 + c; } }
    { const int p = wid * 64 + lane, row = p >> 3, c = (p & 7) ^ ((row >> 1) & 7); krsrc = Krh + (long)row * 64 + c * 8; }
    const unsigned lds0 = (unsigned)(uintptr_t)lds;
    const unsigned kdst = lds0 + OFF_K + wid * 2048, krdst = lds0 + OFF_KR + wid * 1024, vdst = lds0 + OFF_V + wid * 2048;
#define DMA_K(t, slot) do { glds16(ksrc[0] + (long)(t) * 65536, (unsigned)__builtin_amdgcn_readfirstlane(kdst + (slot) * SHM_K)); \
    glds16(ksrc[1] + (long)(t) * 65536, (unsigned)__builtin_amdgcn_readfirstlane(kdst + (slot) * SHM_K + 1024)); \
    glds16(krsrc + (long)(t) * 4096, (unsigned)__builtin_amdgcn_readfirstlane(krdst + (slot) * SHM_KR)); } while (0)
#define DMA_V(t, slot) do { glds16(vsrc[0] + (long)(t) * 65536, (unsigned)__builtin_amdgcn_readfirstlane(vdst + (slot) * SHM_V)); \
    glds16(vsrc[1] + (long)(t) * 65536, (unsigned)__builtin_amdgcn_readfirstlane(vdst + (slot) * SHM_V + 1024)); } while (0)
#define WAIT_BAR(N) asm volatile("s_waitcnt vmcnt(" #N ") lgkmcnt(0)\n\ts_barrier" ::: "memory")
    const int vb0 = (int)(uintptr_t)V_lds + v_rd_base(lane);
    const int NT = seq / 64;
#define RESC(a) do { if (__any((a) < 1.f)) { if (hi == 0) al_l[r32] = (a); asm volatile("s_waitcnt lgkmcnt(0)" ::: "memory"); \
    _Pragma("unroll") for (int d = 0; d < 4; ++d) _Pragma("unroll") for (int r = 0; r < 16; ++r) o[d][r] *= al_l[crow(r, hi)]; } } while (0)
    f32x16 p0, p1; float al = 1.f, mn_; bf16x8 pa0, pa1, pa2, pa3;
    asm volatile("s_waitcnt vmcnt(0) lgkmcnt(0)" ::: "memory");
    DMA_K(0, 0); DMA_V(0, 0); DMA_K(1, 1);
    WAIT_BAR(0);
    int s0 = 2, s1 = 0, s2 = 1;
    for (int j = 0; j < NT; ++j) {
        if (j + 1 < NT) DMA_V(j + 1, s2);
        if (j + 2 < NT) DMA_K(j + 2, s0);
        qkt(p0, p1, K_lds + s1 * SHM_K, Kr_lds + s1 * SHM_KR, qr, qro, r32, hi, negm);
        partialSM(p0, p1, m_reg, negm, al, j == 0); finishSM(p0, p1, al, l_reg, pa0, pa1, pa2, pa3);
        RESC(al);
        pv_d0(o, vb0 + s1 * SHM_V, pa0, pa1, pa2, pa3);
        if (j + 2 < NT) { WAIT_BAR(3); } else { WAIT_BAR(0); }
        { const int t_ = s0; s0 = s1; s1 = s2; s2 = t_; }
    }
#undef RESC
#undef DMA_K
#undef DMA_V
#undef WAIT_BAR
    if (hi == 0) li_l[r32] = l_reg; asm volatile("s_waitcnt lgkmcnt(0)" ::: "memory");
    float rli[16];
#pragma unroll
    for (int r = 0; r < 16; ++r) rli[r] = __builtin_amdgcn_rcpf(li_l[crow(r, hi)]);
    bf16_t* Ow = Ob + (long)(wid * 32) * 1024;
#pragma unroll
    for (int r = 0; r < 16; ++r) { const int orow = crow(r, hi);
#pragma unroll
        for (int d0 = 0; d0 < 4; ++d0) Ow[(long)orow * 1024 + d0 * 32 + r32] = (bf16_t)(cvtpk(o[d0][r] * rli[r], 0.f) & 0xffffu); }
    asm volatile("s_waitcnt lgkmcnt(0)" ::: "memory");
}
}

#define GAS __attribute__((address_space(1)))
#define XB_TMO      128
#define XB_XCNT(j)  (256  + 64 * (j))
#define XB_XSUB(j)  (1280 + 64 * (j))
#define XB_XGEN(j)  (2304 + 64 * (j))
#define XB_TOP      3328
#define XB_TOPGEN   3392
#define XCD_BAR_WORDS 3456
#define XB_SPIN_CAP (1u << 18)

__device__ __forceinline__ unsigned xb_ld(unsigned* p)              { return __hip_atomic_load(p, __ATOMIC_RELAXED, __HIP_MEMORY_SCOPE_AGENT); }
__device__ __forceinline__ unsigned xb_add(unsigned* p, unsigned v) { return __hip_atomic_fetch_add(p, v, __ATOMIC_RELAXED, __HIP_MEMORY_SCOPE_AGENT); }
__device__ __forceinline__ unsigned xb_xcc_id() { return (unsigned)__builtin_amdgcn_s_getreg((3 << 11) | 20) & 0xFu; }
#define XB_SPIN(cond, bar) do { unsigned _sp = 0; while (cond) { __builtin_amdgcn_s_sleep(1); \
    if ((++_sp & 255u) == 0u) { if (xb_ld(&(bar)[XB_TMO])) break; if (_sp > XB_SPIN_CAP) { atomicAdd(&(bar)[XB_TMO], 1u); break; } } } } while (0)

struct XcdBarrier {
    unsigned* bar; unsigned x;
    volatile LAS unsigned* st;
};

__device__ __forceinline__ XcdBarrier xcd_barrier_post(unsigned* bar, volatile LAS unsigned* st) {
    XcdBarrier b; b.bar = bar; b.x = xb_xcc_id(); b.st = st;
    if (threadIdx.x == 0) (void)xb_add(&bar[XB_XCNT(b.x)], 1u);
    return b;
}
__device__ __forceinline__ void xcd_barrier_complete(unsigned* bar, unsigned x, unsigned& nloc, unsigned& nx) {
    const unsigned G = gridDim.x * gridDim.y * gridDim.z;
    unsigned sum, cnt, mine, sp = 0u;
    for (;;) {
        sum = 0u; cnt = 0u; mine = 0u;
#pragma unroll
        for (unsigned j = 0; j < 16; ++j) { const unsigned c = xb_ld(&bar[XB_XCNT(j)]); sum += c; cnt += (c > 0u) ? 1u : 0u; mine = (j == x) ? c : mine; }
        if (sum == G) break;
        __builtin_amdgcn_s_sleep(1);
        if ((++sp & 255u) == 0u) { if (xb_ld(&bar[XB_TMO])) break; if (sp > XB_SPIN_CAP) { atomicAdd(&bar[XB_TMO], 1u); break; } }
    }
    nloc = mine > 0u ? mine : 1u; nx = cnt > 0u ? cnt : 1u;
}

__device__ __forceinline__ void xcd_barrier(const XcdBarrier& b) {
    asm volatile("s_waitcnt vmcnt(0)" ::: "memory");
    __syncthreads();
    if (threadIdx.x == 0) {
        unsigned* bar = b.bar;
        __builtin_amdgcn_s_waitcnt(0);
        unsigned nloc = b.st[0], nx = b.st[1];
        if (nloc == 0u) { xcd_barrier_complete(bar, b.x, nloc, nx); b.st[0] = nloc; b.st[1] = nx; }
        const unsigned old = xb_add(&bar[XB_XSUB(b.x)], 1u);
        const unsigned gen = old / nloc;
        if (old + 1u == (gen + 1u) * nloc) {
            __builtin_amdgcn_fence(__ATOMIC_RELEASE, "agent");
            asm volatile("s_waitcnt vmcnt(0)" ::: "memory");
            const unsigned og = xb_add(&bar[XB_TOP], 1u);
            const unsigned tg = og / nx;
            if (og + 1u == (tg + 1u) * nx) xb_add(&bar[XB_TOPGEN], 1u);
            else XB_SPIN(xb_ld(&bar[XB_TOPGEN]) == tg, bar);
            __builtin_amdgcn_fence(__ATOMIC_ACQUIRE, "agent");
            xb_add(&bar[XB_XGEN(b.x)], 1u);
            asm volatile("s_waitcnt vmcnt(0)" ::: "memory");
        } else {
            XB_SPIN(xb_ld(&bar[XB_XGEN(b.x)]) == gen, bar);
            __builtin_amdgcn_fence(__ATOMIC_ACQUIRE, "agent");
            asm volatile("s_waitcnt vmcnt(0)" ::: "memory");
        }
    }
    __syncthreads();
}

struct Args { const float* in[21]; float* out; unsigned char* ws; };

struct Ctx {
    int tid, lane, wave, vcu, G, gw, NGW;
    LAS unsigned char* lds;
};

__device__ __forceinline__ void tok_info(int t, int& bi, int& pos, int& S) {
    if (t < T_P) { bi = t >> 11; pos = t & (S_P - 1); S = S_P; } else { const int u = t - T_P; bi = 16 + (u >> 13); pos = u & (S_S - 1); S = S_S; }
}

template <bool GATE_REMAP = false>
__device__ __forceinline__ void p0_transpose_item(const float* W, int K, int N, bf16_t* WT, LAS float* scr, int item, int lane) {
    const int nblk = N / 32, kb = item / nblk, nb = item % nblk, k0 = 64 * kb, n0 = 32 * nb;
    int nd0 = n0; if (GATE_REMAP) { const int half = n0 / DFF, cc = n0 % DFF; nd0 = (cc / 128) * 256 + half * 128 + (cc % 128); }
#pragma unroll 8
    for (int i = 0; i < 32; ++i) { const int kk = 2 * i + (lane >> 5); scr[kk * 33 + (lane & 31)] = W[(size_t)(k0 + kk) * N + n0 + (lane & 31)]; }
    asm volatile("s_waitcnt lgkmcnt(0)" ::: "memory");
    const int c = lane & 7;
#pragma unroll
    for (int j = 0; j < 4; ++j) { const int n = (lane >> 3) + 8 * j; const LAS float* s = scr + (8 * c) * 33 + n;
        u32x4 o; o.x = cvtpk(s[0 * 33], s[1 * 33]); o.y = cvtpk(s[2 * 33], s[3 * 33]); o.z = cvtpk(s[4 * 33], s[5 * 33]); o.w = cvtpk(s[6 * 33], s[7 * 33]);
        *(u32x4*)(WT + (size_t)(nd0 + n) * K + k0 + 8 * c) = o; }
    asm volatile("s_waitcnt lgkmcnt(0)" ::: "memory");
}

__device__ __forceinline__ void mod_gemv(const Ctx& X, const float* c_p, const float* c_s, const float* w_ada, const float* b_ada, float* mod, int j0) {
    LAS float* cact = (LAS float*)X.lds;
    for (int i = X.tid; i < 24 * 1024; i += 512) { const float c = i < 16 * 1024 ? c_p[i] : c_s[i - 16 * 1024]; cact[i] = c / (1.f + __expf(-c)); }
    __syncthreads();
    float acc[24];
#pragma unroll
    for (int b = 0; b < 24; ++b) acc[b] = 0.f;
    const int kbeg = X.wave * 128;
#pragma unroll 4
    for (int kk = 0; kk < 128; ++kk) { const int k = kbeg + kk; const float wv = w_ada[(size_t)k * 6144 + j0 + X.lane];
#pragma unroll
        for (int b = 0; b < 24; ++b) acc[b] = fmaf(cact[b * 1024 + k], wv, acc[b]); }
    __syncthreads();
    LAS float* red = (LAS float*)X.lds;
#pragma unroll
    for (int b = 0; b < 24; ++b) red[(X.wave * 24 + b) * 64 + X.lane] = acc[b];
    __syncthreads();
    for (int i = X.tid; i < 24 * 64; i += 512) { const int b = i >> 6, l = i & 63; float s = b_ada[j0 + l];
#pragma unroll
        for (int w = 0; w < 8; ++w) s += red[(w * 24 + b) * 64 + l];
        mod[b * 6144 + j0 + l] = s; }
    __syncthreads();
}

__device__ __forceinline__ void modnorm_phase(const Ctx& X, const float* src_p, const float* src_s, const float* g, const float* mod, int sh_off, int sc_off, bf16_t* H) {
    for (int ch = X.gw; ch < T_ALL / 16; ch += X.NGW) {
        const int t0 = ch * 16; int bi, pos, S; tok_info(t0, bi, pos, S);
        const float* src = t0 < T_P ? src_p : src_s;
        const float* mp = mod + bi * 6144;
        f32x4 gs[4], sh[4];
#pragma unroll
        for (int j = 0; j < 4; ++j) { const int c = X.lane * 4 + 256 * j; const f32x4 gg = *(const f32x4*)(g + c), sc = *(const f32x4*)(mp + sc_off + c);
            gs[j] = gg * (sc + 1.0f); sh[j] = *(const f32x4*)(mp + sh_off + c); }
#pragma unroll 2
        for (int r = 0; r < 16; ++r) {
            const float* xr = src + (size_t)(t0 + r) * DM + X.lane * 4;
            f32x4 v[4]; float ss = 0.f;
#pragma unroll
            for (int j = 0; j < 4; ++j) { v[j] = *(const f32x4*)(xr + 256 * j); ss += (v[j].x * v[j].x + v[j].y * v[j].y) + (v[j].z * v[j].z + v[j].w * v[j].w); }
            const float rstd = rsqrtf(wave_sum(ss) * (1.f / DM) + EPS);
            bf16_t* orow = H + (size_t)(t0 + r) * DM + X.lane * 4;
#pragma unroll
            for (int j = 0; j < 4; ++j) { const f32x4 o = v[j] * rstd * gs[j] + sh[j]; u32x2 w; w.x = cvtpk(o.x, o.y); w.y = cvtpk(o.z, o.w); *(u32x2*)(orow + 256 * j) = w; }
        }
    }
}

__device__ __forceinline__ void p3_phase(const Ctx& X, const bf16_t* Z, const float* conv_w, const float* ga, const float* gq, const float* gkv,
                                         const float* cosT, const float* sinT, bf16_t* YC, bf16_t* CQN, bf16_t* CKVN, bf16_t* KR) {
    const int lane = X.lane, c8 = lane * 8;
    float w0[8], w1[8], w2[8], gav[8], gqv[8], gkvv[8];
#pragma unroll
    for (int j = 0; j < 8; ++j) { w0[j] = conv_w[c8 + j]; w1[j] = conv_w[512 + c8 + j]; w2[j] = conv_w[1024 + c8 + j]; gav[j] = ga[c8 + j];
        gqv[j] = lane < 48 ? gq[c8 + j] : 0.f; gkvv[j] = lane < 32 ? gkv[c8 + j] : 0.f; }
    for (int ch = X.gw; ch < T_ALL / 16; ch += X.NGW) {
        const int t0 = ch * 16; int bi, pos0, S; tok_info(t0, bi, pos0, S);
        float prev[8], cur[8], nxt[8];
#define LOADP(dst, t) do { const u32x4 ha_ = *(const u32x4*)(Z + (size_t)(t) * ZC + c8), ca_ = *(const u32x4*)(Z + (size_t)(t) * ZC + 1024 + c8); \
        float hf_[8], cf_[8]; unpack8(ha_, hf_); unpack8(ca_, cf_); _Pragma("unroll") for (int j = 0; j < 8; ++j) dst[j] = hf_[j] * cf_[j]; } while (0)
        if (pos0 == 0) {
#pragma unroll
            for (int j = 0; j < 8; ++j) prev[j] = 0.f;
        } else LOADP(prev, t0 - 1);
        LOADP(cur, t0);
        for (int i = 0; i < 16; ++i) {
            const int t = t0 + i, pos = pos0 + i;
            if (pos == S - 1) {
#pragma unroll
                for (int j = 0; j < 8; ++j) nxt[j] = 0.f;
            } else LOADP(nxt, t + 1);
            const bf16_t* zr = Z + (size_t)t * ZC;
            float bf[8]; unpack8(*(const u32x4*)(zr + 512 + c8), bf);
            float y[8]; float ss_a = 0.f;
#pragma unroll
            for (int j = 0; j < 8; ++j) { y[j] = bf[j] * (w0[j] * prev[j] + w1[j] * cur[j] + w2[j] * nxt[j]); ss_a += y[j] * y[j]; }
            float q[8]; float ss_q = 0.f;
            if (lane < 48) { unpack8(*(const u32x4*)(zr + 1536 + c8), q);
#pragma unroll
                for (int j = 0; j < 8; ++j) ss_q += q[j] * q[j]; }
            float kv[8]; float ss_k = 0.f;
            if (lane < 32) { unpack8(*(const u32x4*)(zr + 1920 + c8), kv);
#pragma unroll
                for (int j = 0; j < 8; ++j) ss_k += kv[j] * kv[j]; }
#pragma unroll
            for (int o = 1; o < 64; o <<= 1) { ss_a += __shfl_xor(ss_a, o); ss_q += __shfl_xor(ss_q, o); ss_k += __shfl_xor(ss_k, o); }
            const float ra = rsqrtf(ss_a * (1.f / 512.f) + EPS), rq = rsqrtf(ss_q * (1.f / 384.f) + EPS), rk = rsqrtf(ss_k * (1.f / 256.f) + EPS);
#pragma unroll
            for (int j = 0; j < 8; ++j) y[j] = y[j] * ra * gav[j];
            *(u32x4*)(YC + (size_t)t * DM + c8) = pack8(y);
            if (lane < 48) {
#pragma unroll
                for (int j = 0; j < 8; ++j) q[j] = q[j] * rq * gqv[j];
                *(u32x4*)(CQN + (size_t)t * 384 + c8) = pack8(q); }
            if (lane < 32) {
#pragma unroll
                for (int j = 0; j < 8; ++j) kv[j] = kv[j] * rk * gkvv[j];
                *(u32x4*)(CKVN + (size_t)t * 256 + c8) = pack8(kv); }
            if (lane < 8) {
                const u32x2 a = *(const u32x2*)(zr + 2176 + lane * 4), b = *(const u32x2*)(zr + 2176 + 32 + lane * 4);
                const f32x4 c = *(const f32x4*)(cosT + pos * 32 + lane * 4), s = *(const f32x4*)(sinT + pos * 32 + lane * 4);
                const f32x4 x1 = {bflo(a.x), bfhi(a.x), bflo(a.y), bfhi(a.y)}, x2 = {bflo(b.x), bfhi(b.x), bflo(b.y), bfhi(b.y)};
                const f32x4 y1 = x1 * c - x2 * s, y2 = x2 * c + x1 * s;
                u32x2 o1, o2; o1.x = cvtpk(y1.x, y1.y); o1.y = cvtpk(y1.z, y1.w); o2.x = cvtpk(y2.x, y2.y); o2.y = cvtpk(y2.z, y2.w);
                *(u32x2*)(KR + (size_t)t * 64 + lane * 4) = o1; *(u32x2*)(KR + (size_t)t * 64 + 32 + lane * 4) = o2;
            }
#pragma unroll
            for (int j = 0; j < 8; ++j) { prev[j] = cur[j]; cur[j] = nxt[j]; }
        }
#undef LOADP
    }
}

__device__ __forceinline__ void p5b_phase(const Ctx& X, bf16_t* YC, const float* gb) {
    const int c8 = X.lane * 8; float g[8];
#pragma unroll
    for (int j = 0; j < 8; ++j) g[j] = gb[c8 + j];
    for (int ch = X.gw; ch < T_ALL / 16; ch += X.NGW) {
#pragma unroll 4
        for (int i = 0; i < 16; ++i) { bf16_t* p = YC + (size_t)(ch * 16 + i) * DM + 512 + c8;
            float v[8]; unpack8(*(const u32x4*)p, v); float ss = 0.f;
#pragma unroll
            for (int j = 0; j < 8; ++j) ss += v[j] * v[j];
            const float r = rsqrtf(wave_sum(ss) * (1.f / 512.f) + EPS);
#pragma unroll
            for (int j = 0; j < 8; ++j) v[j] = v[j] * r * g[j];
            *(u32x4*)p = pack8(v); }
    }
}

__device__ __forceinline__ void p9_fixup_phase(const Ctx& X, const bf16_t* UB, const float* cw, bf16_t* ACT) {
    const int nitems = (T_ALL / 256) * 2 * 6;
    for (int it = X.gw; it < nitems; it += X.NGW) {
        const int cb = it % 6, tb = it / 6, pm = tb >> 1, bot = tb & 1; const int c0 = cb * 512 + X.lane * 8;
        if (c0 >= DFF) continue;
        const int t = pm * 256 + (bot ? 255 : 0); const int S = t < T_P ? S_P : S_S; const int pos = t & (S - 1);
        const u32x4 zero = {0u, 0u, 0u, 0u};
        const bf16_t* r0; const bf16_t* r1; const bf16_t* r2; bool z0 = false, z2 = false;
        if (!bot) { z0 = (pos == 0); r0 = UB + ((size_t)(pm > 0 ? pm - 1 : 0) * 4 + 3) * UC; r1 = UB + ((size_t)pm * 4 + 0) * UC; r2 = UB + ((size_t)pm * 4 + 1) * UC; }
        else { z2 = (pos == S - 1); r0 = UB + ((size_t)pm * 4 + 2) * UC; r1 = UB + ((size_t)pm * 4 + 3) * UC; r2 = UB + ((size_t)(pm < T_ALL / 256 - 1 ? pm + 1 : pm) * 4 + 0) * UC; }
        float o[8], g[8], a[8], b[8], c[8];
        { const u32x4 x0 = z0 ? zero : *(const u32x4*)(r0 + c0), x1 = *(const u32x4*)(r1 + c0), x2 = z2 ? zero : *(const u32x4*)(r2 + c0);
          unpack8(x0, a); unpack8(x1, b); unpack8(x2, c);
#pragma unroll
          for (int j = 0; j < 8; ++j) g[j] = cw[c0 + j] * a[j] + cw[UC + c0 + j] * b[j] + cw[2 * UC + c0 + j] * c[j]; }
        { const u32x4 x0 = z0 ? zero : *(const u32x4*)(r0 + DFF + c0), x1 = *(const u32x4*)(r1 + DFF + c0), x2 = z2 ? zero : *(const u32x4*)(r2 + DFF + c0);
          unpack8(x0, a); unpack8(x1, b); unpack8(x2, c);
#pragma unroll
          for (int j = 0; j < 8; ++j) { const float v = cw[DFF + c0 + j] * a[j] + cw[UC + DFF + c0 + j] * b[j] + cw[2 * UC + DFF + c0 + j] * c[j]; o[j] = g[j] / (1.f + __expf(-g[j])) * v; } }
        *(u32x4*)(ACT + (size_t)t * DFF + c0) = pack8(o);
    }
}

__device__ __forceinline__ void final_norm_phase(const Ctx& X, float* out, const float* g) {
    f32x4 gv[4];
#pragma unroll
    for (int j = 0; j < 4; ++j) gv[j] = *(const f32x4*)(g + X.lane * 4 + 256 * j);
    for (int ch = X.gw; ch < T_ALL / 16; ch += X.NGW) {
#pragma unroll 2
        for (int r = 0; r < 16; ++r) { float* xr = out + (size_t)(ch * 16 + r) * DM + X.lane * 4;
            f32x4 v[4]; float ss = 0.f;
#pragma unroll
            for (int j = 0; j < 4; ++j) { v[j] = *(const f32x4*)(xr + 256 * j); ss += (v[j].x * v[j].x + v[j].y * v[j].y) + (v[j].z * v[j].z + v[j].w * v[j].w); }
            const float rstd = rsqrtf(wave_sum(ss) * (1.f / DM) + EPS);
#pragma unroll
            for (int j = 0; j < 4; ++j) *(f32x4*)(xr + 256 * j) = v[j] * rstd * gv[j]; }
    }
}

__global__ void __launch_bounds__(512, 2) fwd_kernel(Args args) {
    extern __shared__ __attribute__((aligned(16))) unsigned char lds[];
    cg::grid_group grid = cg::this_grid();
    Ctx X; { int t_ = threadIdx.x; asm volatile("" : "+v"(t_)); X.tid = t_; } X.lane = X.tid & 63; X.wave = __builtin_amdgcn_readfirstlane(X.tid >> 6);
    X.G = gridDim.x; { const int bx = blockIdx.x; X.vcu = (X.G % 8 == 0) ? (bx % 8) * (X.G / 8) + bx / 8 : bx; }
    X.gw = X.vcu * NWAVES + X.wave; X.NGW = X.G * NWAVES; X.lds = (LAS unsigned char*)lds;
    unsigned char* ws = args.ws;
    volatile LAS unsigned* bar_st = (volatile LAS unsigned*)(X.lds + (LDS_BYTES - 64));
    if (threadIdx.x < 2) bar_st[threadIdx.x] = 0u;
    __syncthreads();
    XcdBarrier bar = xcd_barrier_post((unsigned*)ws, bar_st);
    const float* x_p = args.in[0]; const float* x_s = args.in[1];
    float* mod = (float*)(ws + WS_MOD); float* cosT = (float*)(ws + WS_COS); float* sinT = (float*)(ws + WS_SIN);
    bf16_t* Win_t = (bf16_t*)(ws + WS_WIN); bf16_t* Wuq_t = (bf16_t*)(ws + WS_WUQ); bf16_t* Wukv_t = (bf16_t*)(ws + WS_WUKV);
    bf16_t* Wo_t = (bf16_t*)(ws + WS_WO); bf16_t* Wup_t = (bf16_t*)(ws + WS_WUP); bf16_t* Wdn_t = (bf16_t*)(ws + WS_WDN);
    bf16_t* H = (bf16_t*)(ws + WS_H); bf16_t* Z = (bf16_t*)(ws + WS_Z); bf16_t* QB = (bf16_t*)(ws + WS_QB); bf16_t* KVB = (bf16_t*)(ws + WS_KVB);
    bf16_t* CQN = (bf16_t*)(ws + WS_CQN); bf16_t* CKVN = (bf16_t*)(ws + WS_CKVN); bf16_t* KR = (bf16_t*)(ws + WS_KR); bf16_t* YC = (bf16_t*)(ws + WS_YC);
    bf16_t* ACT = (bf16_t*)(ws + WS_ACT); bf16_t* UB = (bf16_t*)(ws + WS_UB);
    float* out = args.out;

    {
#ifndef NO_MODGEMV
        if (blockIdx.x < 96) mod_gemv(X, args.in[2], args.in[3], args.in[4], args.in[5], mod, blockIdx.x * 64);
#endif
        LAS float* scr = (LAS float*)(X.lds + X.wave * 16384);
        constexpr int I_IN = 16 * 70, I_UQ = 6 * 24, I_UKV = 4 * 32, I_O = 16 * 32, I_UP = 16 * 176, I_DN = 44 * 32;
        constexpr int NITEMS = I_IN + I_UQ + I_UKV + I_O + I_UP + I_DN;
        for (int it = X.gw; it < NITEMS; it += X.NGW) {
            int r = it;
            if (r < I_IN) { p0_transpose_item(args.in[7], 1024, 2240, Win_t, scr, r, X.lane); continue; } r -= I_IN;
            if (r < I_UQ) { p0_transpose_item(args.in[10], 384, 768, Wuq_t, scr, r, X.lane); continue; } r -= I_UQ;
            if (r < I_UKV) { p0_transpose_item(args.in[12], 256, 1024, Wukv_t, scr, r, X.lane); continue; } r -= I_UKV;
            if (r < I_O) { p0_transpose_item(args.in[15], 1024, 1024, Wo_t, scr, r, X.lane); continue; } r -= I_O;
            if (r < I_UP) { p0_transpose_item<true>(args.in[17], 1024, 5632, Wup_t, scr, r, X.lane); continue; } r -= I_UP;
            p0_transpose_item(args.in[19], 2816, 1024, Wdn_t, scr, r, X.lane);
        }
        { const u32x4 zero = {0u, 0u, 0u, 0u}; u32x4* p = (u32x4*)(Win_t + (size_t)2240 * 1024);
          for (int i = blockIdx.x * 512 + X.tid; i < 64 * 1024 / 8; i += X.G * 512) p[i] = zero; }
        for (int i = blockIdx.x * 512 + X.tid; i < 8192 * 32; i += X.G * 512) {
            const int pos = i >> 5, k = i & 31;
            const double inv = exp2(-(double)k * (13.287712379549449 / 32.0));
            const double rev = (double)pos * inv * 0.15915494309189535;
            const float fr = (float)(rev - floor(rev));
            cosT[i] = __builtin_amdgcn_cosf(fr); sinT[i] = __builtin_amdgcn_sinf(fr);
        }
    }
    grid.sync();
    modnorm_phase(X, x_p, x_s - (size_t)T_P * DM, args.in[6], mod, 0, 1024, H);
    xcd_barrier(bar);
    {
        pg8::Gemm g{H, Win_t, T_ALL, ZC, 1024}; pg8::StaticOrder S; S.init(T_ALL, ZC, X.G, (int)blockIdx.x, 1024);
        pg8::EpiBf16 E{Z, ZC};
#ifndef NO_BF
        pg8::gemm_phase<pg8::EpiBf16, pg8::StaticOrder, true, true>(X.lds, g, S, E);
#endif
    }
    xcd_barrier(bar);
    p3_phase(X, Z, args.in[8], args.in[13], args.in[9], args.in[11], cosT, sinT, YC, CQN, CKVN, KR);
    xcd_barrier(bar);
    {
        pg8::Gemm g{CQN, Wuq_t, T_ALL, 768, 384}; pg8::StaticOrder S; S.init(T_ALL, 768, X.G, (int)blockIdx.x, 384);
        pg8::EpiBf16 E{QB, 768};
#ifndef NO_BF
        pg8::gemm_phase<pg8::EpiBf16, pg8::StaticOrder, true, true>(X.lds, g, S, E);
#endif
    }
    {
        pg8::Gemm g{CKVN, Wukv_t, T_ALL, 1024, 256}; pg8::StaticOrder S; S.init(T_ALL, 1024, X.G, (int)blockIdx.x, 256);
        pg8::EpiBf16 E{KVB, 1024};
#ifndef NO_BF
        pg8::gemm_phase<pg8::EpiBf16, pg8::StaticOrder, true, true>(X.lds, g, S, E);
#endif
    }
    xcd_barrier(bar);
    {
        for (int L = X.vcu; L < 1536; L += X.G) {
            int rowbase, h, q0, seq;
            if (L < 1024) { const int bh = L >> 5, qb = L & 31; rowbase = T_P + (bh >> 2) * S_S; h = bh & 3; q0 = qb * 256; seq = S_S; }
            else { const int l2 = L - 1024; const int bh = l2 >> 3, qb = l2 & 7; rowbase = (bh >> 2) * S_P; h = bh & 3; q0 = qb * 256; seq = S_P; }
#ifndef NO_ATT
            att::attn_unit(QB + (size_t)(rowbase + q0) * 768 + h * 192, KVB + (size_t)rowbase * 1024 + h * 256, KVB + (size_t)rowbase * 1024 + h * 256 + 128,
                           KR + (size_t)rowbase * 64, YC + (size_t)(rowbase + q0) * 1024 + 512 + h * 128, cosT + q0 * 32, sinT + q0 * 32, seq, (char*)lds);
#endif
        }
    }
    xcd_barrier(bar);
    p5b_phase(X, YC, args.in[14]);
    xcd_barrier(bar);
    {
        pg8::Gemm g{YC, Wo_t, T_ALL, 1024, 1024}; pg8::StaticOrder S; S.init(T_ALL, 1024, X.G, (int)blockIdx.x, 1024);
        pg8::EpiRes E{x_p, x_s - (size_t)T_P * DM, out, mod, 2048, 0};
#ifndef NO_RES
        pg8::gemm_phase<pg8::EpiRes, pg8::StaticOrder, true, true>(X.lds, g, S, E);
#endif
    }
    xcd_barrier(bar);
    modnorm_phase(X, out, out, args.in[16], mod, 3072, 4096, H);
    xcd_barrier(bar);
    {
        pg8::Gemm g{H, Wup_t, T_ALL, UC, 1024}; pg8::StaticOrder S; S.init(T_ALL, UC, X.G, (int)blockIdx.x, 1024);
        pg8::EpiGate E{ACT, UB, args.in[18], (LAS pg8::f32x4*)(X.lds + 131072)};
        pg8::gemm_phase<pg8::EpiGate, pg8::StaticOrder, true, true>(X.lds, g, S, E);
    }
    xcd_barrier(bar);
    p9_fixup_phase(X, UB, args.in[18], ACT);
    xcd_barrier(bar);
    {
        pg8::Gemm g{ACT, Wdn_t, T_ALL, 1024, DFF}; pg8::SplitOrder S; S.init(T_ALL, 1024, X.G, (int)blockIdx.x, DFF, (int)((blockIdx.x >> 3) & 1));
        pg8::EpiRes E{out, out, out, mod, 5120, 0};
        pg8::gemm_phase<pg8::EpiRes, pg8::SplitOrder, true, true>(X.lds, g, S, E);
    }
    xcd_barrier(bar);
    final_norm_phase(X, out, args.in[20]);
}

extern "C" void kernel_launch(void* const* d_in, const int* in_sizes, int n_in, void* d_out, int out_size, void* d_ws, size_t ws_size, hipStream_t stream) {
    static int grid = 0;
    if (grid == 0) {
        if (n_in != 21 || out_size != T_ALL * DM || ws_size < WS_END) { fprintf(stderr, "kernel_launch: unexpected shapes: n_in %d out %d ws %zu (need %zu)\n", n_in, out_size, ws_size, (size_t)WS_END); grid = -1; return; }
        int dev = 0, cus = 0, per_cu = 0;
        hipGetDevice(&dev); hipDeviceGetAttribute(&cus, hipDeviceAttributeMultiprocessorCount, dev);
        if (hipFuncSetAttribute((const void*)fwd_kernel, hipFuncAttributeMaxDynamicSharedMemorySize, LDS_BYTES) != hipSuccess) { fprintf(stderr, "kernel_launch: hipFuncSetAttribute failed\n"); grid = -1; return; }
        if (hipOccupancyMaxActiveBlocksPerMultiprocessor(&per_cu, (const void*)fwd_kernel, 512, LDS_BYTES) != hipSuccess || per_cu < 1) { fprintf(stderr, "kernel_launch: occupancy query says %d\n", per_cu); per_cu = 1; }
        (void)hipGetLastError();
        grid = cus * per_cu;
    }
    if (grid < 0) return;
    if (hipMemsetAsync(d_ws, 0, 16384, stream) != hipSuccess) { fprintf(stderr, "kernel_launch: hipMemsetAsync failed\n"); return; }
    Args a{};
    for (int i = 0; i < 21; ++i) a.in[i] = (const float*)d_in[i];
    a.out = (float*)d_out; a.ws = (unsigned char*)d_ws;
    void* kargs[] = {&a};
    hipError_t e = hipLaunchCooperativeKernel((const void*)fwd_kernel, dim3(grid), dim3(512), kargs, LDS_BYTES, stream);
    if (e != hipSuccess) fprintf(stderr, "kernel_launch: cooperative launch failed: %s (grid %d)\n", hipGetErrorString(e), grid);
}
```
